# Optimizing an MI355X kernel written in HIP

```python
import jax, jax.numpy as jnp
from jax import lax
import numpy as np

D_MODEL = 1024
BATCH = 16
SEQ = 2048
DEPTH = 1
DEC_BATCH = 2
DEC_SEQ = 16384
PAST_LEN = 128

LRU_WIDTH = D_MODEL
LRU_HEADS = 8
LRU_HEAD_DIM = LRU_WIDTH // LRU_HEADS
LRU_CONV = 4
LRU_C = 8.0
GMLP_WIDTH = D_MODEL
GMLP_GROUPS = 8
GMLP_GROUP_DIM = GMLP_WIDTH // GMLP_GROUPS
CHUNK = 128
D_FF = 3 * D_MODEL
FFN_CONV = 3
ALPHA = float((2 * DEPTH) ** 0.25)
BETA = float((8 * DEPTH) ** -0.25)
LN_EPS = 1e-5
OFF_GATE_A = 0
OFF_X_A = OFF_GATE_A + LRU_WIDTH
OFF_UV = OFF_X_A + LRU_WIDTH
OFF_MG_A = OFF_UV + 2 * GMLP_WIDTH
OFF_MG_B = OFF_MG_A + D_MODEL
IN_WIDTH = OFF_MG_B + D_MODEL

kernel_name = "hybrid_rglru_gmlp_encoder"


def layer_norm(x, g, b):
    xf = x.astype(jnp.float32)
    mu = jnp.mean(xf, axis=-1, keepdims=True)
    xc = xf - mu
    var = jnp.mean(xc * xc, axis=-1, keepdims=True)
    y = xc * lax.rsqrt(var + LN_EPS) * g.astype(jnp.float32) + b.astype(jnp.float32)
    return y.astype(x.dtype)


def dwconv(x, w, b, pad_left):
    k_w = w.shape[0]
    s = x.shape[1]
    xp = jnp.pad(x, ((0, 0), (pad_left, k_w - 1 - pad_left), (0, 0)))
    y = xp[:, 0:s] * w[0]
    for k in range(1, k_w):
        y = y + xp[:, k:k + s] * w[k]
    return y + b


def _linear_combine(left, right):
    a1, b1 = left
    a2, b2 = right
    return a1 * a2, a2 * b1 + b2


def rg_lru(xc, wa, ba, wx, bx, lam, reverse):
    bsz, s, w = xc.shape
    xh = xc.reshape(bsz, s, LRU_HEADS, LRU_HEAD_DIM)
    r = jax.nn.sigmoid(jnp.einsum('bshi,hij->bshj', xh, wa).reshape(bsz, s, w) + ba)
    i = jax.nn.sigmoid(jnp.einsum('bshi,hij->bshj', xh, wx).reshape(bsz, s, w) + bx)
    log_a = -LRU_C * jax.nn.softplus(-lam.astype(jnp.float32)) * r.astype(jnp.float32)
    a = jnp.exp(log_a)
    mult = jnp.sqrt(-jnp.expm1(2.0 * log_a))
    bterm = mult * (i * xc).astype(jnp.float32)
    _, h = lax.associative_scan(_linear_combine, (a, bterm), axis=1, reverse=reverse)
    return h.astype(xc.dtype)


def spatial_gate(v, ws, bs):
    bsz, s, gw = v.shape
    vr = v.reshape(bsz, s // CHUNK, CHUNK, GMLP_GROUPS, GMLP_GROUP_DIM)
    sv = jnp.einsum('gpq,bnqgd->bnpgd', ws, vr) + jnp.transpose(bs)[:, :, None]
    return sv.reshape(bsz, s, gw)


def encoder_layer(x, w_in, conv_a_w, conv_a_b, lru_wa, lru_ba, lru_wx, lru_bx, lru_lambda,
                  gmlp_ln_g, gmlp_ln_b, gmlp_ws, gmlp_bs, w_proj_a, w_proj_b, w_out,
                  ln1_g, ln1_b, w_up, ffn_conv_w, ffn_conv_b, w_down, ln2_g, ln2_b):
    z = x @ w_in
    gate_a = z[..., OFF_GATE_A:OFF_X_A]
    xa = z[..., OFF_X_A:OFF_UV]
    uv = jax.nn.gelu(z[..., OFF_UV:OFF_MG_A])
    mg_a = z[..., OFF_MG_A:OFF_MG_B]
    mg_b = z[..., OFF_MG_B:IN_WIDTH]
    xa = dwconv(xa, conv_a_w, conv_a_b, LRU_CONV // 2)
    h = (rg_lru(xa, lru_wa[0], lru_ba[0], lru_wx[0], lru_bx[0], lru_lambda[0], False)
         + rg_lru(xa, lru_wa[1], lru_ba[1], lru_wx[1], lru_bx[1], lru_lambda[1], True))
    y_a = h * jax.nn.gelu(gate_a)
    u = uv[..., :GMLP_WIDTH]
    v = layer_norm(uv[..., GMLP_WIDTH:], gmlp_ln_g, gmlp_ln_b)
    y_b = u * spatial_gate(v, gmlp_ws, gmlp_bs)
    merged = jax.nn.sigmoid(mg_a) * (y_a @ w_proj_a) + jax.nn.sigmoid(mg_b) * (y_b @ w_proj_b)
    x = layer_norm(ALPHA * x + merged @ w_out, ln1_g, ln1_b)
    hup = dwconv(x @ w_up, ffn_conv_w, ffn_conv_b, FFN_CONV // 2)
    ffn = (jax.nn.gelu(hup[..., :D_FF]) * hup[..., D_FF:]) @ w_down
    x = layer_norm(ALPHA * x + ffn, ln2_g, ln2_b)
    return x


def setup_inputs(seed: int = 0) -> dict:
    key = jax.random.key(seed)
    ks = jax.random.split(key, 26)
    f32 = jnp.float32
    L = DEPTH

    def nrm(k, shape, scale):
        return jax.random.normal(k, shape, f32) * scale

    u_lam = jax.random.uniform(ks[9], (L, 2, LRU_WIDTH), f32, 0.9, 0.999)
    a_base = u_lam ** (1.0 / LRU_C)
    lru_lambda = jnp.log(a_base) - jnp.log1p(-a_base)
    return {
        "x_prompt": nrm(ks[0], (BATCH, SEQ, D_MODEL), 1.0),
        "x_sample": nrm(ks[1], (DEC_BATCH, DEC_SEQ, D_MODEL), 1.0),
        "w_in": nrm(ks[2], (L, D_MODEL, IN_WIDTH), D_MODEL ** -0.5),
        "conv_a_w": nrm(ks[3], (L, LRU_CONV, LRU_WIDTH), LRU_CONV ** -0.5),
        "conv_a_b": nrm(ks[4], (L, LRU_WIDTH), 0.01),
        "lru_wa": nrm(ks[5], (L, 2, LRU_HEADS, LRU_HEAD_DIM, LRU_HEAD_DIM), LRU_HEAD_DIM ** -0.5),
        "lru_ba": nrm(ks[6], (L, 2, LRU_WIDTH), 0.01),
        "lru_wx": nrm(ks[7], (L, 2, LRU_HEADS, LRU_HEAD_DIM, LRU_HEAD_DIM), LRU_HEAD_DIM ** -0.5),
        "lru_bx": nrm(ks[8], (L, 2, LRU_WIDTH), 0.01),
        "lru_lambda": lru_lambda,
        "gmlp_ln_g": 1.0 + nrm(ks[10], (L, GMLP_WIDTH), 0.01),
        "gmlp_ln_b": nrm(ks[11], (L, GMLP_WIDTH), 0.01),
        "gmlp_ws": nrm(ks[12], (L, GMLP_GROUPS, CHUNK, CHUNK), 0.5 * CHUNK ** -0.5),
        "gmlp_bs": 1.0 + nrm(ks[13], (L, GMLP_GROUPS, CHUNK), 0.01),
        "w_proj_a": nrm(ks[14], (L, LRU_WIDTH, D_MODEL), BETA * LRU_WIDTH ** -0.5),
        "w_proj_b": nrm(ks[15], (L, GMLP_WIDTH, D_MODEL), BETA * GMLP_WIDTH ** -0.5),
        "w_out": nrm(ks[16], (L, D_MODEL, D_MODEL), BETA * D_MODEL ** -0.5),
        "ln1_g": 1.0 + nrm(ks[17], (L, D_MODEL), 0.01),
        "ln1_b": nrm(ks[18], (L, D_MODEL), 0.01),
        "w_up": nrm(ks[19], (L, D_MODEL, 2 * D_FF), D_MODEL ** -0.5),
        "ffn_conv_w": nrm(ks[20], (L, FFN_CONV, 2 * D_FF), FFN_CONV ** -0.5),
        "ffn_conv_b": nrm(ks[21], (L, 2 * D_FF), 0.01),
        "w_down": nrm(ks[22], (L, D_FF, D_MODEL), BETA * D_FF ** -0.5),
        "ln2_g": 1.0 + nrm(ks[23], (L, D_MODEL), 0.01),
        "ln2_b": nrm(ks[24], (L, D_MODEL), 0.01),
    }


def reference(x_prompt, x_sample, w_in, conv_a_w, conv_a_b, lru_wa, lru_ba, lru_wx, lru_bx,
              lru_lambda, gmlp_ln_g, gmlp_ln_b, gmlp_ws, gmlp_bs, w_proj_a, w_proj_b, w_out,
              ln1_g, ln1_b, w_up, ffn_conv_w, ffn_conv_b, w_down, ln2_g, ln2_b):
    params = (w_in, conv_a_w, conv_a_b, lru_wa, lru_ba, lru_wx, lru_bx, lru_lambda,
              gmlp_ln_g, gmlp_ln_b, gmlp_ws, gmlp_bs, w_proj_a, w_proj_b, w_out,
              ln1_g, ln1_b, w_up, ffn_conv_w, ffn_conv_b, w_down, ln2_g, ln2_b)
    y_prompt = x_prompt
    y_sample = x_sample
    for l in range(DEPTH):
        layer_params = [p[l] for p in params]
        y_prompt = encoder_layer(y_prompt, *layer_params)
        y_sample = encoder_layer(y_sample, *layer_params)
    return (y_prompt, y_sample)
```

```cpp
#include <hip/hip_runtime.h>
#include <hip/hip_cooperative_groups.h>
#include <cstdio>
namespace cg = cooperative_groups;
namespace pg8 {
#define PG8_LAS __attribute__((address_space(3)))
typedef unsigned short bf16_t;
typedef short bf16x8 __attribute__((ext_vector_type(8)));
typedef float f32x4 __attribute__((ext_vector_type(4)));
typedef unsigned u32x4 __attribute__((ext_vector_type(4)));
constexpr int BM = 256, BK = 64, HALF = 128, HTB = HALF * BK * 2  , STAGE_BYTES = 8 * HTB, NXCD = 8, WGM = 8;

__host__ __device__ __forceinline__ int lds_byte(int r, int c) { const int st = (r >> 4) * 2 + (c >> 5), rr = r & 15, cc = c & 31, ob = rr * 64 + cc * 2; return st * 1024 + (ob ^ (((ob >> 9) & 1) << 5)); }
__host__ __device__ __forceinline__ void stage_rc(int b, int& R, int& C) { const int st = b / 1024, sb = b % 1024, swz = sb ^ (((sb >> 9) & 1) << 5); R = (st >> 1) * 16 + swz / 64; C = (st & 1) * 32 + (swz % 64) / 2; }
__host__ __device__ __forceinline__ int perm32(int rho) { const int n = rho >> 4, i = rho & 15; return 8 * (i >> 2) + 4 * n + (i & 3); }

struct Unit { int pm, pn; };
struct Gemm { const bf16_t* A; const bf16_t* Bt; int M, N, K; };

struct StaticOrder {
    int nM, nN, nwg, G, c;
    __host__ __device__ void init(int M, int N, int G_, int c_) { nM = M / BM; nN = N / BM; nwg = nM * nN; G = G_; c = c_; }
    __host__ __device__ bool next(int i, Unit& u) const {
        const long L = (long)i * G + c; if (L >= nwg) return false;
        int wgid = (int)L; { const int q = nwg / NXCD, r = nwg % NXCD, xcd = wgid % NXCD, off = wgid / NXCD; wgid = (xcd < r ? xcd * (q + 1) : r * (q + 1) + (xcd - r) * q) + off; }
        const int nig = WGM * nN, gid = wgid / nig, fm = gid * WGM, gsz = (nM - fm) < WGM ? (nM - fm) : WGM;
        u.pm = fm + ((wgid % nig) % gsz); u.pn = (wgid % nig) / gsz; return true;
    }
    __device__ __forceinline__ void a_ready(const Unit&) const {}
    __device__ __forceinline__ void done(const Unit&) const {}
};

__device__ __forceinline__ unsigned cvt_pk_bf16(float lo, float hi) { unsigned r; asm volatile("v_cvt_pk_bf16_f32 %0, %1, %2" : "=v"(r) : "v"(lo), "v"(hi)); return r; }
typedef float f32x2 __attribute__((ext_vector_type(2)));

template <class Epi, class Sched>
__device__ __forceinline__ void gemm_phase(PG8_LAS unsigned char* lds, const Gemm g, const Sched& S, const Epi& E) {
    int tid = threadIdx.x; asm volatile("" : "+v"(tid));
    const int wid = __builtin_amdgcn_readfirstlane(tid >> 6), lane = tid & 63, wr = wid >> 2, wc = wid & 3, fr = lane & 15, fq = lane >> 4;
    const int K = g.K, nt = K / BK;
    unsigned voffA[2], voffB[2];
#pragma unroll
    for (int i = 0; i < 2; ++i) { int R, C; stage_rc(tid * 16 + i * 8192, R, C); const int Rb = Epi::PERM ? ((R & ~31) + perm32(R & 31)) : R;
        voffA[i] = (unsigned)(R * K + C) * 2u; voffB[i] = (unsigned)(Rb * K + C) * 2u; }
    const size_t kstep = (size_t)(BK * 2);
    const size_t hstep = (size_t)HALF * K * 2;
    const size_t tstep = 2 * hstep;
    const unsigned ldsw = (unsigned)wid * 1024u;
    const int aoff = lds_byte(wr * 64 + fr, fq * 8), boff = lds_byte(wc * 32 + fr, fq * 8);
#define PG8_SA(b, h) (((b) * 2 + (h)) * HTB)
#define PG8_SB(b, h) ((4 + (b) * 2 + (h)) * HTB)
#define PG8_STAGE(bufoff, gbase, voff) do { _Pragma("unroll") for (int _i = 0; _i < 2; ++_i) \
        __builtin_amdgcn_global_load_lds((const unsigned*)((const char*)(gbase) + (voff)[_i]), (PG8_LAS unsigned*)(lds + (bufoff) + ldsw + _i * 8192), 16, 0, 0); } while (0)
#define PG8_LDA(dst, b, h) do { _Pragma("unroll") for (int m = 0; m < 4; ++m) _Pragma("unroll") for (int k = 0; k < 2; ++k) dst[m][k] = *(const PG8_LAS bf16x8*)(lds + PG8_SA(b, h) + aoff + m * 2048 + k * 1024); } while (0)
#define PG8_LDB(dst, b, h) do { _Pragma("unroll") for (int n = 0; n < 2; ++n) _Pragma("unroll") for (int k = 0; k < 2; ++k) dst[n][k] = *(const PG8_LAS bf16x8*)(lds + PG8_SB(b, h) + boff + n * 2048 + k * 1024); } while (0)
#define PG8_MMA(ai, bj, At, Bt) do { __builtin_amdgcn_s_setprio(1); _Pragma("unroll") for (int m = 0; m < 4; ++m) _Pragma("unroll") for (int n = 0; n < 2; ++n) _Pragma("unroll") for (int k = 0; k < 2; ++k) \
        acc[ai][bj][m][n] = __builtin_amdgcn_mfma_f32_16x16x32_bf16(Bt[n][k], At[m][k], acc[ai][bj][m][n], 0, 0, 0); __builtin_amdgcn_s_setprio(0); } while (0)
#define PG8_WAIT_V(n) asm volatile("s_waitcnt vmcnt(" #n ")" ::: "memory")
#define PG8_WAIT_L(n) asm volatile("s_waitcnt lgkmcnt(" #n ")" ::: "memory")
#define PG8_BAR __builtin_amdgcn_s_barrier()
#define PG8_SCHED __builtin_amdgcn_sched_barrier(0)
    Unit cur, nxt; int ui = 0;
    if (!S.next(0, cur)) return;
    f32x4 acc[2][2][4][2];
#pragma unroll
    for (int a = 0; a < 2; ++a)
#pragma unroll
        for (int b = 0; b < 2; ++b)
#pragma unroll
            for (int m = 0; m < 4; ++m)
#pragma unroll
                for (int n = 0; n < 2; ++n) acc[a][b][m][n] = (f32x4){0.f, 0.f, 0.f, 0.f};
    bf16x8 At[4][2], B0[2][2], B1[2][2];
    const char* cA = (const char*)g.A + (size_t)cur.pm * tstep; const char* cB = (const char*)g.Bt + (size_t)cur.pn * tstep;
    S.a_ready(cur);
    PG8_STAGE(PG8_SB(0, 0), cB, voffB); PG8_STAGE(PG8_SA(0, 0), cA, voffA); PG8_STAGE(PG8_SB(0, 1), cB + hstep, voffB); PG8_STAGE(PG8_SA(0, 1), cA + hstep, voffA);
    if (wr == 1) PG8_BAR;
    PG8_WAIT_V(4); PG8_BAR;
    PG8_STAGE(PG8_SB(1, 0), cB + kstep, voffB); PG8_STAGE(PG8_SA(1, 0), cA + kstep, voffA); PG8_STAGE(PG8_SB(1, 1), cB + hstep + kstep, voffB);
    PG8_WAIT_V(6); PG8_BAR;
    for (;;) {
        const bool has_next = S.next(ui + 1, nxt);
        const char* nA = has_next ? (const char*)g.A + (size_t)nxt.pm * tstep : cA; const char* nB = has_next ? (const char*)g.Bt + (size_t)nxt.pn * tstep : cB;
        for (int t = 0; t < nt; t += 2) {
            const bool last = (t == nt - 2);
            const char* a1 = cA + (size_t)(t + 1) * kstep;
            const char* a2 = last ? nA : cA + (size_t)(t + 2) * kstep; const char* b2 = last ? nB : cB + (size_t)(t + 2) * kstep;
            const char* a3 = a2 + kstep; const char* b3 = b2 + kstep;
            if (last && has_next) S.a_ready(nxt);
            PG8_LDB(B0, 0, 0); PG8_SCHED; PG8_LDA(At, 0, 0); PG8_STAGE(PG8_SA(1, 1), a1 + hstep, voffA);
            PG8_WAIT_L(8); PG8_BAR; PG8_WAIT_L(0); PG8_MMA(0, 0, At, B0); PG8_BAR; PG8_SCHED;
            PG8_LDB(B1, 0, 1); PG8_STAGE(PG8_SB(0, 0), b2, voffB);
            PG8_BAR; PG8_WAIT_L(0); PG8_MMA(0, 1, At, B1); PG8_BAR;
            PG8_LDA(At, 0, 1); PG8_STAGE(PG8_SA(0, 0), a2, voffA);
            PG8_BAR; PG8_WAIT_L(0); PG8_MMA(1, 0, At, B0); PG8_BAR; PG8_SCHED;
            PG8_STAGE(PG8_SB(0, 1), b2 + hstep, voffB);
            PG8_WAIT_V(6); PG8_BAR; PG8_MMA(1, 1, At, B1); PG8_BAR;
            PG8_LDB(B0, 1, 0); PG8_SCHED; PG8_LDA(At, 1, 0); PG8_STAGE(PG8_SA(0, 1), a2 + hstep, voffA);
            PG8_WAIT_L(8); PG8_BAR; PG8_WAIT_L(0); PG8_MMA(0, 0, At, B0); PG8_BAR; PG8_SCHED;
            PG8_LDB(B1, 1, 1); PG8_STAGE(PG8_SB(1, 0), b3, voffB);
            PG8_BAR; PG8_WAIT_L(0); PG8_MMA(0, 1, At, B1); PG8_BAR;
            PG8_LDA(At, 1, 1); PG8_STAGE(PG8_SA(1, 0), a3, voffA);
            PG8_BAR; PG8_WAIT_L(0); PG8_MMA(1, 0, At, B0); PG8_BAR; PG8_SCHED;
            PG8_STAGE(PG8_SB(1, 1), b3 + hstep, voffB);
            PG8_WAIT_V(6); PG8_BAR; PG8_MMA(1, 1, At, B1); PG8_BAR;
        }
        if constexpr (!Epi::AFTER_DRAIN) { E(acc, cur, wr, wc, fr, fq); S.done(cur); }
        if (!has_next) break;
#pragma unroll
        for (int a = 0; a < 2; ++a)
#pragma unroll
            for (int b = 0; b < 2; ++b)
#pragma unroll
                for (int m = 0; m < 4; ++m)
#pragma unroll
                    for (int n = 0; n < 2; ++n) acc[a][b][m][n] = (f32x4){0.f, 0.f, 0.f, 0.f};
        cur = nxt; cA = nA; cB = nB; ++ui;
    }
    PG8_WAIT_V(0);
    if (wr == 0) PG8_BAR;
    PG8_BAR;
    if constexpr (Epi::AFTER_DRAIN) { E.fused(acc, cur, wr, wc, fr, fq, lds, wid, lane); S.done(cur); }
#undef PG8_SA
#undef PG8_SB
#undef PG8_STAGE
#undef PG8_LDA
#undef PG8_LDB
#undef PG8_MMA
#undef PG8_WAIT_V
#undef PG8_WAIT_L
#undef PG8_BAR
#undef PG8_SCHED
}
}

using pg8::bf16_t; using pg8::bf16x8; using pg8::f32x4; using pg8::u32x4; using pg8::Unit; using pg8::cvt_pk_bf16;
typedef unsigned u32x2 __attribute__((ext_vector_type(2)));
typedef float f32x2v __attribute__((ext_vector_type(2)));
#define LAS __attribute__((address_space(3)))
constexpr int DM = 1024, TS = 16384  , NSLAB = 4, INW = 6144, DFF = 3072, NTHR = 512;
constexpr float ALPHA = 1.189207115002721f, LN_EPS = 1e-5f;
constexpr size_t WS_WIN = 0, WS_WUP = WS_WIN + (size_t)INW * DM * 2, WS_WD = WS_WUP + (size_t)INW * DM * 2, WS_PA = WS_WD + (size_t)DM * DFF * 2, WS_PB = WS_PA + (size_t)DM * DM * 2,
    WS_WO = WS_PB + (size_t)DM * DM * 2, WS_WG = WS_WO + (size_t)DM * DM * 2, WS_WS = WS_WG + (size_t)32 * 16384 * 2, WS_CFAC = WS_WS + (size_t)8 * 16384 * 2, WS_COLSUM = WS_CFAC + 8192,
    WS_BW = WS_COLSUM + 24576, WS_VST = WS_BW + 24576, WS_ST1 = WS_VST + (size_t)TS * 128, WS_ST2 = WS_ST1 + (size_t)TS * 128, WS_SUM = WS_ST2 + (size_t)TS * 128,
    WS_XB = WS_SUM + (size_t)128 * 4 * 1024 * 4, WS_Z = WS_XB + (size_t)TS * DM * 2, WS_YA = WS_Z + (size_t)TS * INW * 2, WS_YB = WS_YA + (size_t)TS * DM * 2,
    WS_TMP = WS_YB + (size_t)TS * DM * 2, WS_MG = WS_TMP + (size_t)TS * DM * 4, WS_END = WS_MG + (size_t)TS * DM * 2;

struct Params { const float* in[25]; float* out; unsigned char* ws; int ph_lo, ph_hi; };

__device__ __forceinline__ float bflo(unsigned u) { return __uint_as_float(u << 16); }
__device__ __forceinline__ float bfhi(unsigned u) { return __uint_as_float(u & 0xffff0000u); }
__device__ __forceinline__ float fast_rcp(float x) { return __builtin_amdgcn_rcpf(x); }
__device__ __forceinline__ float sigmoid_f(float x) { return fast_rcp(1.f + __expf(-x)); }
__device__ __forceinline__ float gelu_f(float x) { const float u = 1.5957691216057308f * (x + 0.044715f * x * x * x); return x * fast_rcp(1.f + __expf(-u)); }
__device__ __forceinline__ void unpack8(const u32x4 w, float (&f)[8]) { f[0] = bflo(w.x); f[1] = bfhi(w.x); f[2] = bflo(w.y); f[3] = bfhi(w.y); f[4] = bflo(w.z); f[5] = bfhi(w.z); f[6] = bflo(w.w); f[7] = bfhi(w.w); }
__device__ __forceinline__ u32x4 pack8(const float (&f)[8]) { u32x4 w; w.x = cvt_pk_bf16(f[0], f[1]); w.y = cvt_pk_bf16(f[2], f[3]); w.z = cvt_pk_bf16(f[4], f[5]); w.w = cvt_pk_bf16(f[6], f[7]); return w; }

__device__ __forceinline__ void put_stat(float* st, int row, int slot, float s, float q, int fq) {
    s += __shfl_xor(s, 16); s += __shfl_xor(s, 32); q += __shfl_xor(q, 16); q += __shfl_xor(q, 32);
    if (fq == 0) *(f32x2v*)(st + ((size_t)row * 16 + slot) * 2) = (f32x2v){s, q};
}
__device__ __forceinline__ f32x2v get_stat(const float* st, int row, int fq) {
    const f32x4 a = *(const f32x4*)(st + ((size_t)row * 16 + fq * 4) * 2), b = *(const f32x4*)(st + ((size_t)row * 16 + fq * 4 + 2) * 2);
    float s = (a[0] + a[2]) + (b[0] + b[2]), q = (a[1] + a[3]) + (b[1] + b[3]);
    s += __shfl_xor(s, 16); s += __shfl_xor(s, 32); q += __shfl_xor(q, 16); q += __shfl_xor(q, 32);
    const float mean = s * (1.f / 1024.f), var = q * (1.f / 1024.f) - mean * mean;
    return (f32x2v){mean, rsqrtf(var + LN_EPS)};
}

struct EpiZ {
    static constexpr bool PERM = true, AFTER_DRAIN = false;
    bf16_t* Z; float* vst;
    __device__ __forceinline__ void operator()(const f32x4 (&acc)[2][2][4][2], const Unit& u, int wr, int wc, int fr, int fq) const {
        const int type = u.pn >> 2, row0 = u.pm * 256 + wr * 64 + fr, col0 = u.pn * 256 + wc * 32 + 8 * fq;
#pragma unroll
        for (int ai = 0; ai < 2; ++ai)
#pragma unroll
            for (int m = 0; m < 4; ++m) { const int row = row0 + ai * 128 + m * 16; float s = 0.f, q = 0.f;
#pragma unroll
                for (int bj = 0; bj < 2; ++bj) { float v[8];
#pragma unroll
                    for (int j = 0; j < 8; ++j) { const float x = acc[ai][bj][m][j >> 2][j & 3]; v[j] = (type == 1) ? x : (type >= 4 ? sigmoid_f(x) : gelu_f(x)); s += v[j]; q += v[j] * v[j]; }
                    *(u32x4*)(Z + (size_t)row * INW + col0 + bj * 128) = pack8(v); }
                if (type == 3) put_stat(vst, row, (u.pn - 12) * 4 + wc, s, q, fq); }
    }
};
struct EpiProjA {
    static constexpr bool PERM = true, AFTER_DRAIN = false;
    const bf16_t* Z; float* TMP;
    __device__ __forceinline__ void operator()(const f32x4 (&acc)[2][2][4][2], const Unit& u, int wr, int wc, int fr, int fq) const {
        const int row0 = u.pm * 256 + wr * 64 + fr, col0 = u.pn * 256 + wc * 32 + 8 * fq;
#pragma unroll
        for (int ai = 0; ai < 2; ++ai)
#pragma unroll
            for (int m = 0; m < 4; ++m) { const int row = row0 + ai * 128 + m * 16;
#pragma unroll
                for (int bj = 0; bj < 2; ++bj) { float g[8]; unpack8(*(const u32x4*)(Z + (size_t)row * INW + 4096 + col0 + bj * 128), g); float* o = TMP + (size_t)row * DM + col0 + bj * 128;
                    *(f32x4*)o = (f32x4){g[0], g[1], g[2], g[3]} * acc[ai][bj][m][0]; *(f32x4*)(o + 4) = (f32x4){g[4], g[5], g[6], g[7]} * acc[ai][bj][m][1]; } }
    }
};
struct EpiProjB {
    static constexpr bool PERM = true, AFTER_DRAIN = false;
    const bf16_t* Z; const float* TMP; bf16_t* MG;
    __device__ __forceinline__ void operator()(const f32x4 (&acc)[2][2][4][2], const Unit& u, int wr, int wc, int fr, int fq) const {
        const int row0 = u.pm * 256 + wr * 64 + fr, col0 = u.pn * 256 + wc * 32 + 8 * fq;
#pragma unroll
        for (int ai = 0; ai < 2; ++ai)
#pragma unroll
            for (int m = 0; m < 4; ++m) { const int row = row0 + ai * 128 + m * 16;
#pragma unroll
                for (int bj = 0; bj < 2; ++bj) { float g[8]; unpack8(*(const u32x4*)(Z + (size_t)row * INW + 5120 + col0 + bj * 128), g); const float* t = TMP + (size_t)row * DM + col0 + bj * 128;
                    const f32x4 t0 = *(const f32x4*)t, t1 = *(const f32x4*)(t + 4); float v[8];
#pragma unroll
                    for (int j = 0; j < 4; ++j) { v[j] = t0[j] + g[j] * acc[ai][bj][m][0][j]; v[4 + j] = t1[j] + g[4 + j] * acc[ai][bj][m][1][j]; }
                    *(u32x4*)(MG + (size_t)row * DM + col0 + bj * 128) = pack8(v); } }
    }
};
struct EpiOut1 {
    static constexpr bool PERM = true, AFTER_DRAIN = false;
    const float* xs; float* outs; bf16_t* P1B; float* st1;
    __device__ __forceinline__ void operator()(const f32x4 (&acc)[2][2][4][2], const Unit& u, int wr, int wc, int fr, int fq) const {
        const int row0 = u.pm * 256 + wr * 64 + fr, col0 = u.pn * 256 + wc * 32 + 8 * fq;
#pragma unroll
        for (int ai = 0; ai < 2; ++ai)
#pragma unroll
            for (int m = 0; m < 4; ++m) { const int row = row0 + ai * 128 + m * 16; float s = 0.f, q = 0.f;
#pragma unroll
                for (int bj = 0; bj < 2; ++bj) { const size_t off = (size_t)row * DM + col0 + bj * 128; const f32x4 x0 = *(const f32x4*)(xs + off), x1 = *(const f32x4*)(xs + off + 4);
                    const f32x4 p0 = x0 * ALPHA + acc[ai][bj][m][0], p1 = x1 * ALPHA + acc[ai][bj][m][1]; float v[8];
#pragma unroll
                    for (int j = 0; j < 4; ++j) { v[j] = p0[j]; v[4 + j] = p1[j]; s += p0[j] + p1[j]; q += p0[j] * p0[j] + p1[j] * p1[j]; }
                    *(f32x4*)(outs + off) = p0; *(f32x4*)(outs + off + 4) = p1; *(u32x4*)(P1B + off) = pack8(v); }
                put_stat(st1, row, u.pn * 4 + wc, s, q, fq); }
    }
};
struct EpiUp {
    static constexpr bool PERM = true, AFTER_DRAIN = false;
    bf16_t* HUP; const float* st1; const float* colsum; const float* bW;
    __device__ __forceinline__ void operator()(const f32x4 (&acc)[2][2][4][2], const Unit& u, int wr, int wc, int fr, int fq) const {
        const int row0 = u.pm * 256 + wr * 64 + fr, col0 = u.pn * 256 + wc * 32 + 8 * fq;
        f32x4 cs[2][2], bw[2][2];
#pragma unroll
        for (int bj = 0; bj < 2; ++bj)
#pragma unroll
            for (int n = 0; n < 2; ++n) { cs[bj][n] = *(const f32x4*)(colsum + col0 + bj * 128 + 4 * n); bw[bj][n] = *(const f32x4*)(bW + col0 + bj * 128 + 4 * n); }
#pragma unroll
        for (int ai = 0; ai < 2; ++ai)
#pragma unroll
            for (int m = 0; m < 4; ++m) { const int row = row0 + ai * 128 + m * 16; const f32x2v mr = get_stat(st1, row, fq);
#pragma unroll
                for (int bj = 0; bj < 2; ++bj) { const f32x4 h0 = (acc[ai][bj][m][0] - cs[bj][0] * mr.x) * mr.y + bw[bj][0], h1 = (acc[ai][bj][m][1] - cs[bj][1] * mr.x) * mr.y + bw[bj][1];
                    u32x4 w; w.x = cvt_pk_bf16(h0[0], h0[1]); w.y = cvt_pk_bf16(h0[2], h0[3]); w.z = cvt_pk_bf16(h1[0], h1[1]); w.w = cvt_pk_bf16(h1[2], h1[3]);
                    *(u32x4*)(HUP + (size_t)row * INW + col0 + bj * 128) = w; } }
    }
};
struct EpiDown {
    static constexpr bool PERM = true, AFTER_DRAIN = false;
    float* outs; const float* st1; float* st2; const float* g1; const float* b1;
    __device__ __forceinline__ void operator()(const f32x4 (&acc)[2][2][4][2], const Unit& u, int wr, int wc, int fr, int fq) const {
        const int row0 = u.pm * 256 + wr * 64 + fr, col0 = u.pn * 256 + wc * 32 + 8 * fq;
        f32x4 gg[2][2], bb[2][2];
#pragma unroll
        for (int bj = 0; bj < 2; ++bj)
#pragma unroll
            for (int n = 0; n < 2; ++n) { gg[bj][n] = *(const f32x4*)(g1 + col0 + bj * 128 + 4 * n) * ALPHA; bb[bj][n] = *(const f32x4*)(b1 + col0 + bj * 128 + 4 * n) * ALPHA; }
#pragma unroll
        for (int ai = 0; ai < 2; ++ai)
#pragma unroll
            for (int m = 0; m < 4; ++m) { const int row = row0 + ai * 128 + m * 16; const f32x2v mr = get_stat(st1, row, fq); float s = 0.f, q = 0.f;
#pragma unroll
                for (int bj = 0; bj < 2; ++bj) { float* o = outs + (size_t)row * DM + col0 + bj * 128; const f32x4 x0 = *(const f32x4*)o, x1 = *(const f32x4*)(o + 4);
                    const f32x4 p0 = (x0 - mr.x) * mr.y * gg[bj][0] + bb[bj][0] + acc[ai][bj][m][0], p1 = (x1 - mr.x) * mr.y * gg[bj][1] + bb[bj][1] + acc[ai][bj][m][1];
#pragma unroll
                    for (int j = 0; j < 4; ++j) { s += p0[j] + p1[j]; q += p0[j] * p0[j] + p1[j] * p1[j]; }
                    *(f32x4*)o = p0; *(f32x4*)(o + 4) = p1; }
                put_stat(st2, row, u.pn * 4 + wc, s, q, fq); }
    }
};

struct Ctx {
    Params p;
    __device__ __forceinline__ const float* in(int i) const { return p.in[i]; }
    __device__ __forceinline__ float* out() const { return p.out; }
#define WSP(name, type, off) __device__ __forceinline__ type* name() const { return (type*)(p.ws + (off)); }
    WSP(WinT, bf16_t, WS_WIN) WSP(WupT, bf16_t, WS_WUP) WSP(WdT, bf16_t, WS_WD) WSP(PaT, bf16_t, WS_PA) WSP(PbT, bf16_t, WS_PB) WSP(WoT, bf16_t, WS_WO) WSP(WG, bf16_t, WS_WG) WSP(WS, bf16_t, WS_WS)
    WSP(XB, bf16_t, WS_XB) WSP(Z, bf16_t, WS_Z) WSP(YA, bf16_t, WS_YA) WSP(YB, bf16_t, WS_YB) WSP(MG, bf16_t, WS_MG) WSP(ACT, bf16_t, WS_TMP)
    WSP(cfac, float, WS_CFAC) WSP(colsum, float, WS_COLSUM) WSP(bW, float, WS_BW) WSP(vst, float, WS_VST) WSP(st1, float, WS_ST1) WSP(st2, float, WS_ST2) WSP(sum, float, WS_SUM) WSP(TMP, float, WS_TMP)
#undef WSP
};
__device__ __forceinline__ const float* slab_x(const Ctx& X, int s) { return s < 2 ? X.in(0) + (size_t)s * TS * DM : X.in(1) + (size_t)(s - 2) * TS * DM; }
__device__ __forceinline__ float* slab_out(const Ctx& X, int s) { return X.out() + (size_t)s * TS * DM; }
__device__ __forceinline__ int slab_seqlen(int s) { return s < 2 ? 2048 : 16384; }

__device__ __forceinline__ void transpose_tile(const float* src, bf16_t* dst, int K, int N, int k0, int n0, const float* scale, LAS float* tile) {
    int tid = threadIdx.x; asm volatile("" : "+v"(tid));
#pragma unroll
    for (int i = 0; i < 8; ++i) { const int idx = tid + NTHR * i, r = idx >> 6, c = idx & 63; float v = src[(size_t)(k0 + r) * N + n0 + c]; if (scale) v *= scale[k0 + r]; tile[r * 65 + c] = v; }
    __syncthreads();
#pragma unroll
    for (int i = 0; i < 4; ++i) { const int idx = tid + NTHR * i, r = idx >> 5, c2 = idx & 31;
        *(unsigned*)(dst + (size_t)(n0 + r) * K + k0 + 2 * c2) = cvt_pk_bf16(tile[(2 * c2) * 65 + r], tile[(2 * c2 + 1) * 65 + r]); }
    __syncthreads();
}
__device__ __forceinline__ void convert_x(const float* xs, bf16_t* XB) {
    int tid = threadIdx.x; asm volatile("" : "+v"(tid));
    const size_t gtid = (size_t)blockIdx.x * NTHR + tid, gth = (size_t)gridDim.x * NTHR;
    for (size_t g = gtid; g < (size_t)TS * DM / 8; g += gth) { const f32x4 a = ((const f32x4*)xs)[2 * g], b = ((const f32x4*)xs)[2 * g + 1];
        u32x4 w; w.x = cvt_pk_bf16(a[0], a[1]); w.y = cvt_pk_bf16(a[2], a[3]); w.z = cvt_pk_bf16(b[0], b[1]); w.w = cvt_pk_bf16(b[2], b[3]); ((u32x4*)XB)[g] = w; }
}
__device__ __forceinline__ void phase_prep(const Ctx& X, LAS unsigned char* lds) {
    LAS float* tile = (LAS float*)lds;
    int tid = threadIdx.x; asm volatile("" : "+v"(tid));
    for (int t = blockIdx.x; t < 4736; t += gridDim.x) {
        if (t < 1536) { transpose_tile(X.in(2), X.WinT(), 1024, 6144, (t / 96) * 64, (t % 96) * 64, nullptr, tile); }
        else if (t < 3072) { const int u = t - 1536; transpose_tile(X.in(19), X.WupT(), 1024, 6144, (u / 96) * 64, (u % 96) * 64, X.in(17), tile); }
        else if (t < 3840) { const int u = t - 3072; transpose_tile(X.in(22), X.WdT(), 3072, 1024, (u / 16) * 64, (u % 16) * 64, nullptr, tile); }
        else if (t < 4096) { const int v = t - 3840; transpose_tile(X.in(14), X.PaT(), 1024, 1024, (v / 16) * 64, (v % 16) * 64, nullptr, tile); }
        else if (t < 4352) { const int v = t - 4096; transpose_tile(X.in(15), X.PbT(), 1024, 1024, (v / 16) * 64, (v % 16) * 64, nullptr, tile); }
        else if (t < 4608) { const int v = t - 4352; transpose_tile(X.in(16), X.WoT(), 1024, 1024, (v / 16) * 64, (v % 16) * 64, nullptr, tile); }
        else { const int u = t - 4608, mat = u >> 2, q = u & 3, type = mat >> 4, dh = mat & 15;
            const int dir = dh >> 3, h = dh & 7;
            if (type == 0) transpose_tile(X.in(5) + (size_t)dh * 16384, X.WG() + (size_t)((dir * 2 + 0) * 8 + h) * 16384, 128, 128, (q >> 1) * 64, (q & 1) * 64, nullptr, tile);
            else transpose_tile(X.in(7) + (size_t)dh * 16384, X.WG() + (size_t)((dir * 2 + 1) * 8 + h) * 16384, 128, 128, (q >> 1) * 64, (q & 1) * 64, nullptr, tile); }
    }
    const size_t gtid = (size_t)blockIdx.x * NTHR + tid, gth = (size_t)gridDim.x * NTHR;
    for (size_t i = gtid; i < 8 * 16384; i += gth) { const float v = X.in(12)[i]; unsigned u = __float_as_uint(v); u += 0x7FFFu + ((u >> 16) & 1u); X.WS()[i] = (bf16_t)(u >> 16); }
    for (size_t i = gtid; i < 2048; i += gth) { const float nl = -X.in(9)[i]; const float sp = nl > 15.f ? nl : log1pf(__expf(nl)); X.cfac()[i] = -8.0f * sp; }
    for (int u = blockIdx.x; u < 96; u += gridDim.x) { const int n = u * 64 + (tid & 63), kg = tid >> 6; float s = 0.f;
#pragma unroll 8
        for (int k = kg; k < 1024; k += 8) s += X.in(18)[k] * X.in(19)[(size_t)k * 6144 + n];
        tile[kg * 64 + (tid & 63)] = s; __syncthreads();
        if (tid < 64) { float t = 0.f;
#pragma unroll
            for (int j = 0; j < 8; ++j) t += tile[j * 64 + tid]; X.bW()[n] = t; }
        __syncthreads(); }
    convert_x(slab_x(X, 0), X.XB());
}
__device__ __forceinline__ void colsum_job(const Ctx& X) {
    int tid = threadIdx.x; asm volatile("" : "+v"(tid));
    const int lane = tid & 63, gw = blockIdx.x * 8 + (tid >> 6), nw = gridDim.x * 8;
    for (int n = gw; n < 6144; n += nw) { const u32x4* p = (const u32x4*)(X.WupT() + (size_t)n * 1024) + lane * 2; float f[8], s = 0.f;
        unpack8(p[0], f);
#pragma unroll
        for (int j = 0; j < 8; ++j) s += f[j];
        unpack8(p[1], f);
#pragma unroll
        for (int j = 0; j < 8; ++j) s += f[j];
#pragma unroll
        for (int o = 32; o >= 1; o >>= 1) s += __shfl_xor(s, o);
        if (lane == 0) X.colsum()[n] = s; }
}

constexpr int XCF_LD = 132, XCB_LD = 136, XCB_OFF = 128 * XCF_LD * 4, CARRY_OFF = XCB_OFF + 128 * XCB_LD * 2;
template <int PASS, int DIR>
__device__ __forceinline__ void lru_dir(const Ctx& X, int c, int h, LAS unsigned char* lds, float (&hsum)[8][4]) {
    int tid = threadIdx.x; asm volatile("" : "+v"(tid)); const int lane = tid & 63, w = tid >> 6, fr = lane & 15, fq = lane >> 4;
    LAS float* XCF = (LAS float*)lds; LAS bf16_t* XCB = (LAS bf16_t*)(lds + XCB_OFF); LAS float* CARRY = (LAS float*)(lds + CARRY_OFF);
    const bf16_t* WgR = X.WG() + (size_t)((DIR * 2 + 0) * 8 + h) * 16384; const bf16_t* WgI = X.WG() + (size_t)((DIR * 2 + 1) * 8 + h) * 16384;
    bf16x8 BR[4], BI[4];
#pragma unroll
    for (int ks = 0; ks < 4; ++ks) { BR[ks] = *(const bf16x8*)(WgR + (16 * w + fr) * 128 + 32 * ks + 8 * fq); BI[ks] = *(const bf16x8*)(WgI + (16 * w + fr) * 128 + 32 * ks + 8 * fq); }
    const int ch = h * 128 + 16 * w + fr;
    const float ba = X.in(6)[DIR * 1024 + ch], bx = X.in(8)[DIR * 1024 + ch], cf = X.cfac()[DIR * 1024 + ch];
    float av[8][4], bv[8][4];
#pragma unroll
    for (int m = 0; m < 8; ++m) { f32x4 aR = {0.f, 0.f, 0.f, 0.f}, aI = {0.f, 0.f, 0.f, 0.f};
#pragma unroll
        for (int ks = 0; ks < 4; ++ks) { const bf16x8 a = *(const LAS bf16x8*)(XCB + (16 * m + fr) * XCB_LD + 32 * ks + 8 * fq);
            aR = __builtin_amdgcn_mfma_f32_16x16x32_bf16(a, BR[ks], aR, 0, 0, 0); aI = __builtin_amdgcn_mfma_f32_16x16x32_bf16(a, BI[ks], aI, 0, 0, 0); }
#pragma unroll
        for (int r = 0; r < 4; ++r) { const float rg = sigmoid_f(aR[r] + ba), ig = sigmoid_f(aI[r] + bx), la = cf * rg, a = __expf(la), x2 = 2.f * la;
            const float pl = -x2 * (1.f + 0.5f * x2 * (1.f + 0.33333333f * x2 * (1.f + 0.25f * x2 * (1.f + 0.2f * x2 * (1.f + 0.16666667f * x2)))));
            const float sel = x2 > -0.25f ? 1.f : 0.f, om = sel * pl + (1.f - sel) * (1.f - a * a);
            const float xc = XCF[(16 * m + 4 * fq + r) * XCF_LD + 16 * w + fr];
            av[m][r] = a; bv[m][r] = sqrtf(om) * ig * xc; }
        __builtin_amdgcn_sched_barrier(0); }
    float carry = 0.f, CA = 1.f, CB = 0.f;
    if (PASS == 2) carry = CARRY[DIR * 128 + 16 * w + fr];
#pragma unroll
    for (int mm = 0; mm < 8; ++mm) { const int m = DIR == 0 ? mm : 7 - mm;
        float A, B;
        if (DIR == 0) { A = av[m][0]; B = bv[m][0];
#pragma unroll
            for (int r = 1; r < 4; ++r) { B = av[m][r] * B + bv[m][r]; A *= av[m][r]; } }
        else { A = av[m][3]; B = bv[m][3];
#pragma unroll
            for (int r = 2; r >= 0; --r) { B = av[m][r] * B + bv[m][r]; A *= av[m][r]; } }
        { const float A1 = DIR == 0 ? __shfl_up(A, 16) : __shfl_down(A, 16), B1 = DIR == 0 ? __shfl_up(B, 16) : __shfl_down(B, 16);
          if (DIR == 0 ? fq >= 1 : fq <= 2) { B = A * B1 + B; A = A1 * A; } }
        { const float A2 = DIR == 0 ? __shfl_up(A, 32) : __shfl_down(A, 32), B2 = DIR == 0 ? __shfl_up(B, 32) : __shfl_down(B, 32);
          if (DIR == 0 ? fq >= 2 : fq <= 1) { B = A * B2 + B; A = A2 * A; } }
        const float TA = __shfl(A, (DIR == 0 ? 48 : 0) + fr), TB = __shfl(B, (DIR == 0 ? 48 : 0) + fr);
        if (PASS == 1) { CB = TA * CB + TB; CA *= TA; }
        else {
            float EA = DIR == 0 ? __shfl_up(A, 16) : __shfl_down(A, 16), EB = DIR == 0 ? __shfl_up(B, 16) : __shfl_down(B, 16);
            if (DIR == 0 ? fq == 0 : fq == 3) { EA = 1.f; EB = 0.f; }
            float hc = EA * carry + EB;
            if (DIR == 0) {
#pragma unroll
                for (int r = 0; r < 4; ++r) { hc = av[m][r] * hc + bv[m][r]; hsum[m][r] += hc; } }
            else {
#pragma unroll
                for (int r = 3; r >= 0; --r) { hc = av[m][r] * hc + bv[m][r]; hsum[m][r] += hc; } }
            carry = TA * carry + TB;
        }
    }
    if (PASS == 1 && fq == 0) { X.sum()[(size_t)((c * 2 + DIR) * 2 + 0) * 1024 + ch] = CA; X.sum()[(size_t)((c * 2 + DIR) * 2 + 1) * 1024 + ch] = CB; }
}
template <int PASS>
__device__ __forceinline__ void lru_job(const Ctx& X, int s, int c, int h, LAS unsigned char* lds) {
    int tid = threadIdx.x; asm volatile("" : "+v"(tid));
    LAS float* XCF = (LAS float*)lds; LAS bf16_t* XCB = (LAS bf16_t*)(lds + XCB_OFF); LAS float* CARRY = (LAS float*)(lds + CARRY_OFF);
    const int L = slab_seqlen(s), t0 = c * 128, sb = (t0 / L) * L, se = sb + L;
    const int cg8 = tid & 15, rg = tid >> 4, ch0 = h * 128 + cg8 * 8;
    {
        float cw[4][8], cb[8];
#pragma unroll
        for (int k = 0; k < 4; ++k) { const f32x4 a = *(const f32x4*)(X.in(3) + k * 1024 + ch0), b = *(const f32x4*)(X.in(3) + k * 1024 + ch0 + 4);
#pragma unroll
            for (int j = 0; j < 4; ++j) { cw[k][j] = a[j]; cw[k][4 + j] = b[j]; } }
        { const f32x4 a = *(const f32x4*)(X.in(4) + ch0), b = *(const f32x4*)(X.in(4) + ch0 + 4);
#pragma unroll
          for (int j = 0; j < 4; ++j) { cb[j] = a[j]; cb[4 + j] = b[j]; } }
        float xin[7][8];
#pragma unroll
        for (int j = 0; j < 7; ++j) { const int t = t0 + 4 * rg - 2 + j; u32x4 wv = {0u, 0u, 0u, 0u};
            if (t >= sb && t < se) wv = *(const u32x4*)(X.Z() + (size_t)t * INW + 1024 + ch0);
            unpack8(wv, xin[j]); }
#pragma unroll
        for (int r = 0; r < 4; ++r) { float v[8];
#pragma unroll
            for (int e = 0; e < 8; ++e) v[e] = cb[e] + cw[0][e] * xin[r][e] + cw[1][e] * xin[r + 1][e] + cw[2][e] * xin[r + 2][e] + cw[3][e] * xin[r + 3][e];
            LAS float* o = XCF + (4 * rg + r) * XCF_LD + cg8 * 8;
            *(LAS f32x4*)o = (f32x4){v[0], v[1], v[2], v[3]}; *(LAS f32x4*)(o + 4) = (f32x4){v[4], v[5], v[6], v[7]};
            *(LAS u32x4*)(XCB + (4 * rg + r) * XCB_LD + cg8 * 8) = pack8(v); }
    }
    if (PASS == 2 && tid < 256) {
        const int dir = tid >> 7, chn = h * 128 + (tid & 127), c_first = sb / 128, c_last = se / 128 - 1; float Hc = 0.f;
        if (dir == 0) {
#pragma unroll 8
            for (int cc = c_first; cc < c; ++cc) { const float A = X.sum()[(size_t)((cc * 2 + 0) * 2 + 0) * 1024 + chn], Bv = X.sum()[(size_t)((cc * 2 + 0) * 2 + 1) * 1024 + chn]; Hc = A * Hc + Bv; } }
        else {
#pragma unroll 8
            for (int cc = c_last; cc > c; --cc) { const float A = X.sum()[(size_t)((cc * 2 + 1) * 2 + 0) * 1024 + chn], Bv = X.sum()[(size_t)((cc * 2 + 1) * 2 + 1) * 1024 + chn]; Hc = A * Hc + Bv; } }
        CARRY[tid] = Hc;
    }
    __syncthreads();
    float hsum[8][4];
#pragma unroll
    for (int m = 0; m < 8; ++m)
#pragma unroll
        for (int r = 0; r < 4; ++r) hsum[m][r] = 0.f;
    __builtin_amdgcn_sched_barrier(0);
    lru_dir<PASS, 0>(X, c, h, lds, hsum);
    __builtin_amdgcn_sched_barrier(0);
    lru_dir<PASS, 1>(X, c, h, lds, hsum);
    __builtin_amdgcn_sched_barrier(0);
    if (PASS == 2) {
        const int lane = tid & 63, w = tid >> 6, fr = lane & 15, fq = lane >> 4;
#pragma unroll
        for (int m = 0; m < 8; ++m)
#pragma unroll
            for (int r = 0; r < 4; ++r) XCF[(16 * m + 4 * fq + r) * XCF_LD + 16 * w + fr] = hsum[m][r];
        __syncthreads();
#pragma unroll
        for (int r = 0; r < 4; ++r) { const int tok = 4 * rg + r; LAS const float* y = XCF + tok * XCF_LD + cg8 * 8; const f32x4 y0 = *(LAS const f32x4*)y, y1 = *(LAS const f32x4*)(y + 4);
            float g[8]; unpack8(*(const u32x4*)(X.Z() + (size_t)(t0 + tok) * INW + ch0), g);
            float v[8];
#pragma unroll
            for (int j = 0; j < 4; ++j) { v[j] = y0[j] * g[j]; v[4 + j] = y1[j] * g[4 + j]; }
            *(u32x4*)(X.YA() + (size_t)(t0 + tok) * DM + ch0) = pack8(v); }
    }
    __syncthreads();
}

__device__ __forceinline__ int vt_off(int d, int q) { return d * 136 + (((q >> 3) ^ ((d >> 3) & 15)) << 3) + (q & 7); }
__device__ __forceinline__ void gmlp_job(const Ctx& X, int c, int g, LAS unsigned char* lds) {
    int tid = threadIdx.x; asm volatile("" : "+v"(tid)); const int lane = tid & 63, w = tid >> 6, fr = lane & 15, fq = lane >> 4;
    LAS float* SV = (LAS float*)lds; LAS bf16_t* VT = (LAS bf16_t*)(lds + XCB_OFF); LAS float* MU = (LAS float*)(lds + CARRY_OFF);
    const int t0 = c * 128, cg8 = tid & 15, rg = tid >> 4, ch0 = g * 128 + cg8 * 8;
    if (tid < 128) { const float* p = X.vst() + (size_t)(t0 + tid) * 32; float s = 0.f, q = 0.f;
#pragma unroll
        for (int i = 0; i < 8; ++i) { const f32x4 a = *(const f32x4*)(p + 4 * i); s += a[0] + a[2]; q += a[1] + a[3]; }
        const float mean = s * (1.f / 1024.f), var = q * (1.f / 1024.f) - mean * mean; MU[tid * 2] = mean; MU[tid * 2 + 1] = rsqrtf(var + LN_EPS); }
    bf16x8 Aw[4];
#pragma unroll
    for (int ks = 0; ks < 4; ++ks) Aw[ks] = *(const bf16x8*)(X.WS() + (size_t)g * 16384 + (16 * w + fr) * 128 + 32 * ks + 8 * fq);
    __syncthreads();
    {
        float lg[8], lb[8], vn[4][8];
        { const f32x4 a = *(const f32x4*)(X.in(10) + ch0), b = *(const f32x4*)(X.in(10) + ch0 + 4), cc = *(const f32x4*)(X.in(11) + ch0), d = *(const f32x4*)(X.in(11) + ch0 + 4);
#pragma unroll
          for (int j = 0; j < 4; ++j) { lg[j] = a[j]; lg[4 + j] = b[j]; lb[j] = cc[j]; lb[4 + j] = d[j]; } }
#pragma unroll
        for (int r = 0; r < 4; ++r) { const int tok = 4 * rg + r; float v[8]; unpack8(*(const u32x4*)(X.Z() + (size_t)(t0 + tok) * INW + 3072 + ch0), v);
            const float mean = MU[tok * 2], rstd = MU[tok * 2 + 1];
#pragma unroll
            for (int e = 0; e < 8; ++e) vn[r][e] = (v[e] - mean) * rstd * lg[e] + lb[e]; }
#pragma unroll
        for (int e = 0; e < 8; ++e) { u32x2 pk; pk.x = cvt_pk_bf16(vn[0][e], vn[1][e]); pk.y = cvt_pk_bf16(vn[2][e], vn[3][e]); *(LAS u32x2*)(VT + vt_off(cg8 * 8 + e, 4 * rg)) = pk; }
    }
    __syncthreads();
    f32x4 acc[8];
#pragma unroll
    for (int dt = 0; dt < 8; ++dt) { acc[dt] = (f32x4){0.f, 0.f, 0.f, 0.f};
#pragma unroll
        for (int ks = 0; ks < 4; ++ks) { const bf16x8 b = *(const LAS bf16x8*)(VT + vt_off(16 * dt + fr, 32 * ks + 8 * fq)); acc[dt] = __builtin_amdgcn_mfma_f32_16x16x32_bf16(Aw[ks], b, acc[dt], 0, 0, 0); } }
#pragma unroll
    for (int dt = 0; dt < 8; ++dt)
#pragma unroll
        for (int r = 0; r < 4; ++r) SV[(16 * w + 4 * fq + r) * XCF_LD + 16 * dt + fr] = acc[dt][r];
    __syncthreads();
#pragma unroll
    for (int r = 0; r < 4; ++r) { const int tok = 4 * rg + r; LAS const float* y = SV + tok * XCF_LD + cg8 * 8; const f32x4 y0 = *(LAS const f32x4*)y, y1 = *(LAS const f32x4*)(y + 4);
        float uu[8]; unpack8(*(const u32x4*)(X.Z() + (size_t)(t0 + tok) * INW + 2048 + ch0), uu); const float bsv = X.in(13)[g * 128 + tok];
        float v[8];
#pragma unroll
        for (int j = 0; j < 4; ++j) { v[j] = uu[j] * (y0[j] + bsv); v[4 + j] = uu[4 + j] * (y1[j] + bsv); }
        *(u32x4*)(X.YB() + (size_t)(t0 + tok) * DM + ch0) = pack8(v); }
    __syncthreads();
}

__device__ __forceinline__ void convgate_phase(const Ctx& X, int s) {
    const bf16_t* HUP = X.Z(); const float* cwp = X.in(20); const float* cbp = X.in(21);
    const int L = slab_seqlen(s);
    int tid = threadIdx.x; asm volatile("" : "+v"(tid));
    const int gtid = blockIdx.x * NTHR + tid, gth = gridDim.x * NTHR;
    for (int item = gtid; item < 1024 * 384; item += gth) { const int rb = item / 384, cgp = item - rb * 384, j0 = cgp * 8, r0 = rb * 16, sb = (r0 / L) * L, se = sb + L;
        float wg[3][8], wv[3][8], bg[8], bvv[8];
#pragma unroll
        for (int k = 0; k < 3; ++k) { const f32x4 a = *(const f32x4*)(cwp + k * 6144 + j0), b = *(const f32x4*)(cwp + k * 6144 + j0 + 4), c2 = *(const f32x4*)(cwp + k * 6144 + 3072 + j0), d = *(const f32x4*)(cwp + k * 6144 + 3072 + j0 + 4);
#pragma unroll
            for (int j = 0; j < 4; ++j) { wg[k][j] = a[j]; wg[k][4 + j] = b[j]; wv[k][j] = c2[j]; wv[k][4 + j] = d[j]; } }
        { const f32x4 a = *(const f32x4*)(cbp + j0), b = *(const f32x4*)(cbp + j0 + 4), c2 = *(const f32x4*)(cbp + 3072 + j0), d = *(const f32x4*)(cbp + 3072 + j0 + 4);
#pragma unroll
          for (int j = 0; j < 4; ++j) { bg[j] = a[j]; bg[4 + j] = b[j]; bvv[j] = c2[j]; bvv[4 + j] = d[j]; } }
        float pg[8], pv[8], cg_[8], cv[8], ng[8], nv[8];
        { u32x4 a = {0u, 0u, 0u, 0u}, b = {0u, 0u, 0u, 0u}; if (r0 - 1 >= sb) { a = *(const u32x4*)(HUP + (size_t)(r0 - 1) * INW + j0); b = *(const u32x4*)(HUP + (size_t)(r0 - 1) * INW + 3072 + j0); } unpack8(a, pg); unpack8(b, pv); }
        unpack8(*(const u32x4*)(HUP + (size_t)r0 * INW + j0), cg_); unpack8(*(const u32x4*)(HUP + (size_t)r0 * INW + 3072 + j0), cv);
#pragma unroll 4
        for (int i = 0; i < 16; ++i) { const int r = r0 + i; u32x4 a = {0u, 0u, 0u, 0u}, b = {0u, 0u, 0u, 0u};
            if (r + 1 < se) { a = *(const u32x4*)(HUP + (size_t)(r + 1) * INW + j0); b = *(const u32x4*)(HUP + (size_t)(r + 1) * INW + 3072 + j0); }
            unpack8(a, ng); unpack8(b, nv); float o[8];
#pragma unroll
            for (int e = 0; e < 8; ++e) { const float yg = bg[e] + wg[0][e] * pg[e] + wg[1][e] * cg_[e] + wg[2][e] * ng[e], yv = bvv[e] + wv[0][e] * pv[e] + wv[1][e] * cv[e] + wv[2][e] * nv[e];
                o[e] = gelu_f(yg) * yv; pg[e] = cg_[e]; cg_[e] = ng[e]; pv[e] = cv[e]; cv[e] = nv[e]; }
            *(u32x4*)(X.ACT() + (size_t)r * DFF + j0) = pack8(o); }
    }
}
__device__ __forceinline__ void final_ln(const Ctx& X, int s) {
    int tid = threadIdx.x; asm volatile("" : "+v"(tid));
    float* outs = slab_out(X, s); const int lane = tid & 63, gw = blockIdx.x * 8 + (tid >> 6), nw = gridDim.x * 8;
    f32x4 g[4], b[4];
#pragma unroll
    for (int i = 0; i < 4; ++i) { g[i] = *(const f32x4*)(X.in(23) + i * 256 + lane * 4); b[i] = *(const f32x4*)(X.in(24) + i * 256 + lane * 4); }
    for (int row = gw; row < TS; row += nw) { float sv = 0.f, qv = 0.f;
        if (lane < 16) { const f32x2v p = *(const f32x2v*)(X.st2() + ((size_t)row * 16 + lane) * 2); sv = p.x; qv = p.y; }
#pragma unroll
        for (int o = 8; o >= 1; o >>= 1) { sv += __shfl_xor(sv, o); qv += __shfl_xor(qv, o); }
        sv = __shfl(sv, 0); qv = __shfl(qv, 0);
        const float mean = sv * (1.f / 1024.f), rstd = rsqrtf(qv * (1.f / 1024.f) - mean * mean + LN_EPS);
        float* p = outs + (size_t)row * DM + lane * 4;
#pragma unroll
        for (int i = 0; i < 4; ++i) { const f32x4 v = *(const f32x4*)(p + i * 256); *(f32x4*)(p + i * 256) = (v - mean) * rstd * g[i] + b[i]; } }
}

constexpr int N_PHASES = 34;
#ifndef PMASK
#define PMASK 0x3ff
#endif
__global__ void __launch_bounds__(NTHR, 2) mega(Params p) {
    extern __shared__ __attribute__((aligned(16))) unsigned char lds_raw[];
    LAS unsigned char* lds = (LAS unsigned char*)lds_raw;
    cg::grid_group grid = cg::this_grid();
    Ctx X; X.p = p;
    const int G = gridDim.x, bx = blockIdx.x;
    for (int ph = p.ph_lo; ph < p.ph_hi; ++ph) {
        if (ph > p.ph_lo) grid.sync();
        if (ph == 0) { if (PMASK & 0x100) phase_prep(X, lds); continue; }
        if (ph == N_PHASES - 1) { if (PMASK & 0x200) final_ln(X, NSLAB - 1); continue; }
        const int s = (ph - 1) >> 3, k = (ph - 1) & 7;
        if (k == 0 && (PMASK & 1)) {
            pg8::Gemm g{X.XB(), X.WinT(), TS, INW, DM}; pg8::StaticOrder S; S.init(TS, INW, G, bx); EpiZ E{X.Z(), X.vst()};
            pg8::gemm_phase<EpiZ, pg8::StaticOrder>(lds, g, S, E);
        } else if (k == 1 && (PMASK & 2)) {
            if (s == 0) colsum_job(X); else final_ln(X, s - 1);
            for (int j = bx; j < 2048; j += G) { const int c = (j >> 3) & 127, h = j & 7; if (j < 1024) lru_job<1>(X, s, c, h, lds); else gmlp_job(X, c, h, lds); }
        } else if (k == 2 && (PMASK & 4)) {
            for (int j = bx; j < 1024; j += G) lru_job<2>(X, s, j >> 3, j & 7, lds);
        } else if (k == 3 && (PMASK & 8)) {
            { pg8::Gemm g{X.YA(), X.PaT(), TS, DM, DM}; pg8::StaticOrder S; S.init(TS, DM, G, bx); EpiProjA E{X.Z(), X.TMP()}; pg8::gemm_phase<EpiProjA, pg8::StaticOrder>(lds, g, S, E); }
            { pg8::Gemm g{X.YB(), X.PbT(), TS, DM, DM}; pg8::StaticOrder S; S.init(TS, DM, G, bx); EpiProjB E{X.Z(), X.TMP(), X.MG()}; pg8::gemm_phase<EpiProjB, pg8::StaticOrder>(lds, g, S, E); }
        } else if (k == 4 && (PMASK & 16)) {
            pg8::Gemm g{X.MG(), X.WoT(), TS, DM, DM}; pg8::StaticOrder S; S.init(TS, DM, G, bx); EpiOut1 E{slab_x(X, s), slab_out(X, s), X.YA(), X.st1()};
            pg8::gemm_phase<EpiOut1, pg8::StaticOrder>(lds, g, S, E);
        } else if (k == 5 && (PMASK & 32)) {
            pg8::Gemm g{X.YA(), X.WupT(), TS, INW, DM}; pg8::StaticOrder S; S.init(TS, INW, G, bx); EpiUp E{X.Z(), X.st1(), X.colsum(), X.bW()};
            pg8::gemm_phase<EpiUp, pg8::StaticOrder>(lds, g, S, E);
        } else if (k == 6 && (PMASK & 64)) {
            convgate_phase(X, s); if (s + 1 < NSLAB) convert_x(slab_x(X, s + 1), X.XB());
        } else if (PMASK & 128) {
            pg8::Gemm g{X.ACT(), X.WdT(), TS, DM, DFF}; pg8::StaticOrder S; S.init(TS, DM, G, bx); EpiDown E{slab_out(X, s), X.st1(), X.st2(), X.in(17), X.in(18)};
            pg8::gemm_phase<EpiDown, pg8::StaticOrder>(lds, g, S, E);
        }
    }
}

extern "C" void kernel_launch(void* const* d_in, const int* in_sizes, int n_in, void* d_out, int out_size, void* d_ws, size_t ws_size, hipStream_t stream) {
    constexpr int LDS_BYTES = pg8::STAGE_BYTES;
    static int grid = 0;
    if (grid == 0) {
        int dev = 0, cus = 0, per_cu = 0;
        if (n_in != 25 || ws_size < WS_END) { fprintf(stderr, "kernel_launch: need 25 inputs and %zu bytes of workspace (got %d, %zu)\n", (size_t)WS_END, n_in, ws_size); grid = -1; return; }
        (void)hipGetDevice(&dev); (void)hipDeviceGetAttribute(&cus, hipDeviceAttributeMultiprocessorCount, dev);
        (void)hipFuncSetAttribute((const void*)mega, hipFuncAttributeMaxDynamicSharedMemorySize, LDS_BYTES);
        (void)hipOccupancyMaxActiveBlocksPerMultiprocessor(&per_cu, (const void*)mega, NTHR, LDS_BYTES);
        grid = cus;
    }
    if (grid < 0) return;
    Params p{};
    for (int i = 0; i < 25; ++i) p.in[i] = (const float*)d_in[i];
    p.out = (float*)d_out; p.ws = (unsigned char*)d_ws;
#ifndef MK_SPLIT
    p.ph_lo = 0; p.ph_hi = N_PHASES;
    void* args[] = {&p};
    hipError_t e = hipLaunchCooperativeKernel((const void*)mega, dim3(grid), dim3(NTHR), args, LDS_BYTES, stream);
    if (e != hipSuccess) fprintf(stderr, "cooperative launch failed: %s (grid %d)\n", hipGetErrorString(e), grid);
#else
    for (int ph = 0; ph < N_PHASES; ++ph) { p.ph_lo = ph; p.ph_hi = ph + 1; void* args[] = {&p};
        hipError_t e = hipLaunchCooperativeKernel((const void*)mega, dim3(grid), dim3(NTHR), args, LDS_BYTES, stream);
        if (e != hipSuccess) { fprintf(stderr, "launch %d failed: %s\n", ph, hipGetErrorString(e)); break; } }
#endif
}
```

```cpp
#include <hip/hip_runtime.h>
#include <hip/hip_cooperative_groups.h>
#include <cstdio>
namespace cg = cooperative_groups;
namespace pg8 {
#define PG8_LAS __attribute__((address_space(3)))
typedef unsigned short bf16_t;
typedef short bf16x8 __attribute__((ext_vector_type(8)));
typedef float f32x4 __attribute__((ext_vector_type(4)));
typedef unsigned u32x4 __attribute__((ext_vector_type(4)));
constexpr int BM = 256, BK = 64, HALF = 128, HTB = HALF * BK * 2  , STAGE_BYTES = 8 * HTB, NXCD = 8, WGM = 8;

__host__ __device__ __forceinline__ int lds_byte(int r, int c) { const int st = (r >> 4) * 2 + (c >> 5), rr = r & 15, cc = c & 31, ob = rr * 64 + cc * 2; return st * 1024 + (ob ^ (((ob >> 9) & 1) << 5)); }
__host__ __device__ __forceinline__ void stage_rc(int b, int& R, int& C) { const int st = b / 1024, sb = b % 1024, swz = sb ^ (((sb >> 9) & 1) << 5); R = (st >> 1) * 16 + swz / 64; C = (st & 1) * 32 + (swz % 64) / 2; }
__host__ __device__ __forceinline__ int perm32(int rho) { const int n = rho >> 4, i = rho & 15; return 8 * (i >> 2) + 4 * n + (i & 3); }

struct Unit { int pm, pn; };
struct Gemm { const bf16_t* A; const bf16_t* Bt; int M, N, K; };

struct StaticOrder {
    int nM, nN, nwg, G, c;
    __host__ __device__ void init(int M, int N, int G_, int c_) { nM = M / BM; nN = N / BM; nwg = nM * nN; G = G_; c = c_; }
    __host__ __device__ bool next(int i, Unit& u) const {
        const long L = (long)i * G + c; if (L >= nwg) return false;
        int wgid = (int)L; { const int q = nwg / NXCD, r = nwg % NXCD, xcd = wgid % NXCD, off = wgid / NXCD; wgid = (xcd < r ? xcd * (q + 1) : r * (q + 1) + (xcd - r) * q) + off; }
        const int nig = WGM * nN, gid = wgid / nig, fm = gid * WGM, gsz = (nM - fm) < WGM ? (nM - fm) : WGM;
        u.pm = fm + ((wgid % nig) % gsz); u.pn = (wgid % nig) / gsz; return true;
    }
    __device__ __forceinline__ void a_ready(const Unit&) const {}
    __device__ __forceinline__ void done(const Unit&) const {}
};

__device__ __forceinline__ unsigned cvt_pk_bf16(float lo, float hi) { unsigned r; asm volatile("v_cvt_pk_bf16_f32 %0, %1, %2" : "=v"(r) : "v"(lo), "v"(hi)); return r; }
typedef float f32x2 __attribute__((ext_vector_type(2)));

template <class Epi, class Sched>
__device__ __forceinline__ void gemm_phase(PG8_LAS unsigned char* lds, const Gemm g, const Sched& S, const Epi& E) {
    int tid = threadIdx.x; asm volatile("" : "+v"(tid));
    const int wid = __builtin_amdgcn_readfirstlane(tid >> 6), lane = tid & 63, wr = wid >> 2, wc = wid & 3, fr = lane & 15, fq = lane >> 4;
    const int K = g.K, nt = K / BK;
    unsigned voffA[2], voffB[2];
#pragma unroll
    for (int i = 0; i < 2; ++i) { int R, C; stage_rc(tid * 16 + i * 8192, R, C); const int Rb = Epi::PERM ? ((R & ~31) + perm32(R & 31)) : R;
        voffA[i] = (unsigned)(R * K + C) * 2u; voffB[i] = (unsigned)(Rb * K + C) * 2u; }
    const size_t kstep = (size_t)(BK * 2);
    const size_t hstep = (size_t)HALF * K * 2;
    const size_t tstep = 2 * hstep;
    const unsigned ldsw = (unsigned)wid * 1024u;
    const int aoff = lds_byte(wr * 64 + fr, fq * 8), boff = lds_byte(wc * 32 + fr, fq * 8);
#define PG8_SA(b, h) (((b) * 2 + (h)) * HTB)
#define PG8_SB(b, h) ((4 + (b) * 2 + (h)) * HTB)
#define PG8_STAGE(bufoff, gbase, voff) do { _Pragma("unroll") for (int _i = 0; _i < 2; ++_i) \
        __builtin_amdgcn_global_load_lds((const unsigned*)((const char*)(gbase) + (voff)[_i]), (PG8_LAS unsigned*)(lds + (bufoff) + ldsw + _i * 8192), 16, 0, 0); } while (0)
#define PG8_LDA(dst, b, h) do { _Pragma("unroll") for (int m = 0; m < 4; ++m) _Pragma("unroll") for (int k = 0; k < 2; ++k) dst[m][k] = *(const PG8_LAS bf16x8*)(lds + PG8_SA(b, h) + aoff + m * 2048 + k * 1024); } while (0)
#define PG8_LDB(dst, b, h) do { _Pragma("unroll") for (int n = 0; n < 2; ++n) _Pragma("unroll") for (int k = 0; k < 2; ++k) dst[n][k] = *(const PG8_LAS bf16x8*)(lds + PG8_SB(b, h) + boff + n * 2048 + k * 1024); } while (0)
#define PG8_MMA(ai, bj, At, Bt) do { __builtin_amdgcn_s_setprio(1); _Pragma("unroll") for (int m = 0; m < 4; ++m) _Pragma("unroll") for (int n = 0; n < 2; ++n) _Pragma("unroll") for (int k = 0; k < 2; ++k) \
        acc[ai][bj][m][n] = __builtin_amdgcn_mfma_f32_16x16x32_bf16(Bt[n][k], At[m][k], acc[ai][bj][m][n], 0, 0, 0); __builtin_amdgcn_s_setprio(0); } while (0)
#define PG8_WAIT_V(n) asm volatile("s_waitcnt vmcnt(" #n ")" ::: "memory")
#define PG8_WAIT_L(n) asm volatile("s_waitcnt lgkmcnt(" #n ")" ::: "memory")
#define PG8_BAR __builtin_amdgcn_s_barrier()
#define PG8_SCHED __builtin_amdgcn_sched_barrier(0)
    Unit cur, nxt; int ui = 0;
    if (!S.next(0, cur)) return;
    f32x4 acc[2][2][4][2];
#pragma unroll
    for (int a = 0; a < 2; ++a)
#pragma unroll
        for (int b = 0; b < 2; ++b)
#pragma unroll
            for (int m = 0; m < 4; ++m)
#pragma unroll
                for (int n = 0; n < 2; ++n) acc[a][b][m][n] = (f32x4){0.f, 0.f, 0.f, 0.f};
    bf16x8 At[4][2], B0[2][2], B1[2][2];
    const char* cA = (const char*)g.A + (size_t)cur.pm * tstep; const char* cB = (const char*)g.Bt + (size_t)cur.pn * tstep;
    S.a_ready(cur);
    PG8_STAGE(PG8_SB(0, 0), cB, voffB); PG8_STAGE(PG8_SA(0, 0), cA, voffA); PG8_STAGE(PG8_SB(0, 1), cB + hstep, voffB); PG8_STAGE(PG8_SA(0, 1), cA + hstep, voffA);
    if (wr == 1) PG8_BAR;
    PG8_WAIT_V(4); PG8_BAR;
    PG8_STAGE(PG8_SB(1, 0), cB + kstep, voffB); PG8_STAGE(PG8_SA(1, 0), cA + kstep, voffA); PG8_STAGE(PG8_SB(1, 1), cB + hstep + kstep, voffB);
    PG8_WAIT_V(6); PG8_BAR;
    for (;;) {
        const bool has_next = S.next(ui + 1, nxt);
        const char* nA = has_next ? (const char*)g.A + (size_t)nxt.pm * tstep : cA; const char* nB = has_next ? (const char*)g.Bt + (size_t)nxt.pn * tstep : cB;
        for (int t = 0; t < nt; t += 2) {
            if constexpr (Epi::MID) { if (t == nt / 2) E.mid(acc, cur, wr, wc, fr, fq); }
            const bool last = (t == nt - 2);
            const char* a1 = cA + (size_t)(t + 1) * kstep;
            const char* a2 = last ? nA : cA + (size_t)(t + 2) * kstep; const char* b2 = last ? nB : cB + (size_t)(t + 2) * kstep;
            const char* a3 = a2 + kstep; const char* b3 = b2 + kstep;
            if (last && has_next) S.a_ready(nxt);
            PG8_LDB(B0, 0, 0); PG8_SCHED; PG8_LDA(At, 0, 0); PG8_STAGE(PG8_SA(1, 1), a1 + hstep, voffA);
            PG8_WAIT_L(8); PG8_BAR; PG8_WAIT_L(0); PG8_MMA(0, 0, At, B0); PG8_BAR; PG8_SCHED;
            PG8_LDB(B1, 0, 1); PG8_STAGE(PG8_SB(0, 0), b2, voffB);
            PG8_BAR; PG8_WAIT_L(0); PG8_MMA(0, 1, At, B1); PG8_BAR;
            PG8_LDA(At, 0, 1); PG8_STAGE(PG8_SA(0, 0), a2, voffA);
            PG8_BAR; PG8_WAIT_L(0); PG8_MMA(1, 0, At, B0); PG8_BAR; PG8_SCHED;
            PG8_STAGE(PG8_SB(0, 1), b2 + hstep, voffB);
            PG8_WAIT_V(6); PG8_BAR; PG8_MMA(1, 1, At, B1); PG8_BAR;
            PG8_LDB(B0, 1, 0); PG8_SCHED; PG8_LDA(At, 1, 0); PG8_STAGE(PG8_SA(0, 1), a2 + hstep, voffA);
            PG8_WAIT_L(8); PG8_BAR; PG8_WAIT_L(0); PG8_MMA(0, 0, At, B0); PG8_BAR; PG8_SCHED;
            PG8_LDB(B1, 1, 1); PG8_STAGE(PG8_SB(1, 0), b3, voffB);
            PG8_BAR; PG8_WAIT_L(0); PG8_MMA(0, 1, At, B1); PG8_BAR;
            PG8_LDA(At, 1, 1); PG8_STAGE(PG8_SA(1, 0), a3, voffA);
            PG8_BAR; PG8_WAIT_L(0); PG8_MMA(1, 0, At, B0); PG8_BAR; PG8_SCHED;
            PG8_STAGE(PG8_SB(1, 1), b3 + hstep, voffB);
            PG8_WAIT_V(6); PG8_BAR; PG8_MMA(1, 1, At, B1); PG8_BAR;
        }
        if constexpr (!Epi::AFTER_DRAIN) { E(acc, cur, wr, wc, fr, fq); S.done(cur); }
        if (!has_next) break;
#pragma unroll
        for (int a = 0; a < 2; ++a)
#pragma unroll
            for (int b = 0; b < 2; ++b)
#pragma unroll
                for (int m = 0; m < 4; ++m)
#pragma unroll
                    for (int n = 0; n < 2; ++n) acc[a][b][m][n] = (f32x4){0.f, 0.f, 0.f, 0.f};
        cur = nxt; cA = nA; cB = nB; ++ui;
    }
    PG8_WAIT_V(0);
    if (wr == 0) PG8_BAR;
    PG8_BAR;
    if constexpr (Epi::AFTER_DRAIN) { E.fused(acc, cur, wr, wc, fr, fq, lds, wid, lane); S.done(cur); }
#undef PG8_SA
#undef PG8_SB
#undef PG8_STAGE
#undef PG8_LDA
#undef PG8_LDB
#undef PG8_MMA
#undef PG8_WAIT_V
#undef PG8_WAIT_L
#undef PG8_BAR
#undef PG8_SCHED
}
}

using pg8::bf16_t; using pg8::bf16x8; using pg8::f32x4; using pg8::u32x4; using pg8::Unit; using pg8::cvt_pk_bf16;
typedef unsigned u32x2 __attribute__((ext_vector_type(2)));
typedef float f32x2v __attribute__((ext_vector_type(2)));
#define LAS __attribute__((address_space(3)))
constexpr int DM = 1024, TS = 16384  , NSLAB = 4, INW = 6144, DFF = 3072, NTHR = 512;
constexpr float ALPHA = 1.189207115002721f, LN_EPS = 1e-5f;
constexpr size_t WS_WIN = 0, WS_WUP = WS_WIN + (size_t)INW * DM * 2, WS_WD = WS_WUP + (size_t)INW * DM * 2, WS_PA = WS_WD + (size_t)DM * DFF * 2, WS_PB = WS_PA + (size_t)DM * DM * 2,
    WS_WO = WS_PB + (size_t)DM * DM * 2, WS_WG = WS_WO + (size_t)DM * DM * 2, WS_WS = WS_WG + (size_t)32 * 16384 * 2, WS_CFAC = WS_WS + (size_t)8 * 16384 * 2, WS_COLSUM = WS_CFAC + 8192,
    WS_BW = WS_COLSUM + 24576, WS_VST = WS_BW + 24576, WS_ST1 = WS_VST + (size_t)TS * 128, WS_ST2 = WS_ST1 + (size_t)TS * 128, WS_SUM = WS_ST2 + (size_t)TS * 128,
    WS_XB = WS_SUM + (size_t)128 * 4 * 1024 * 4, WS_Z = WS_XB + (size_t)TS * DM * 2, WS_YA = WS_Z + (size_t)TS * INW * 2, WS_YB = WS_YA + (size_t)TS * DM * 2,
    WS_TMP = WS_YB + (size_t)TS * DM * 2, WS_MG = WS_TMP + (size_t)TS * DM * 4, WS_END = WS_MG + (size_t)TS * DM * 2, WS_BAR = WS_END;

struct Params { const float* in[25]; float* out; unsigned char* ws; int ph_lo, ph_hi, dbl, pad; };

__device__ __forceinline__ float bflo(unsigned u) { return __uint_as_float(u << 16); }
__device__ __forceinline__ float bfhi(unsigned u) { return __uint_as_float(u & 0xffff0000u); }
__device__ __forceinline__ float fast_rcp(float x) { return __builtin_amdgcn_rcpf(x); }
__device__ __forceinline__ float sigmoid_f(float x) { return fast_rcp(1.f + __builtin_amdgcn_exp2f(x * -1.4426950408889634f)); }
__device__ __forceinline__ float gelu_f(float x) { const float x2 = x * x, p = x2 * -0.10294324f + -2.3022082f; return x * fast_rcp(1.f + __builtin_amdgcn_exp2f(x * p)); }
__device__ __forceinline__ void unpack8(const u32x4 w, float (&f)[8]) { f[0] = bflo(w.x); f[1] = bfhi(w.x); f[2] = bflo(w.y); f[3] = bfhi(w.y); f[4] = bflo(w.z); f[5] = bfhi(w.z); f[6] = bflo(w.w); f[7] = bfhi(w.w); }
__device__ __forceinline__ u32x4 pack8(const float (&f)[8]) { u32x4 w; w.x = cvt_pk_bf16(f[0], f[1]); w.y = cvt_pk_bf16(f[2], f[3]); w.z = cvt_pk_bf16(f[4], f[5]); w.w = cvt_pk_bf16(f[6], f[7]); return w; }

__device__ __forceinline__ void put_stat(float* st, int row, int slot, float s, float q, int fq) {
    s += __shfl_xor(s, 16); s += __shfl_xor(s, 32); q += __shfl_xor(q, 16); q += __shfl_xor(q, 32);
    if (fq == 0) *(f32x2v*)(st + ((size_t)row * 16 + slot) * 2) = (f32x2v){s, q};
}
__device__ __forceinline__ f32x2v get_stat(const float* st, int row, int fq) {
    const f32x4 a = *(const f32x4*)(st + ((size_t)row * 16 + fq * 4) * 2), b = *(const f32x4*)(st + ((size_t)row * 16 + fq * 4 + 2) * 2);
    float s = (a[0] + a[2]) + (b[0] + b[2]), q = (a[1] + a[3]) + (b[1] + b[3]);
    s += __shfl_xor(s, 16); s += __shfl_xor(s, 32); q += __shfl_xor(q, 16); q += __shfl_xor(q, 32);
    const float mean = s * (1.f / 1024.f), var = q * (1.f / 1024.f) - mean * mean;
    return (f32x2v){mean, rsqrtf(var + LN_EPS)};
}

struct EpiZ {
    static constexpr bool PERM = true, AFTER_DRAIN = false, MID = false;
    bf16_t* Z; float* vst;
    __device__ __forceinline__ void operator()(const f32x4 (&acc)[2][2][4][2], const Unit& u, int wr, int wc, int fr, int fq) const {
        const int type = u.pn >> 2, row0 = u.pm * 256 + wr * 64 + fr, col0 = u.pn * 256 + wc * 32 + 8 * fq;
#pragma unroll
        for (int ai = 0; ai < 2; ++ai)
#pragma unroll
            for (int m = 0; m < 4; ++m) { const int row = row0 + ai * 128 + m * 16; float s = 0.f, q = 0.f;
#pragma unroll
                for (int bj = 0; bj < 2; ++bj) { float v[8];
#pragma unroll
                    for (int j = 0; j < 8; ++j) { const float x = acc[ai][bj][m][j >> 2][j & 3]; v[j] = (type == 1) ? x : (type >= 4 ? sigmoid_f(x) : gelu_f(x)); }
                    if (type == 3) {
#pragma unroll
                        for (int j = 0; j < 8; ++j) { s += v[j]; q += v[j] * v[j]; } }
                    *(u32x4*)(Z + (size_t)row * INW + col0 + bj * 128) = pack8(v); }
                if (type == 3) put_stat(vst, row, (u.pn - 12) * 4 + wc, s, q, fq); }
    }
};
struct EpiProj {
    static constexpr bool PERM = true, AFTER_DRAIN = false, MID = true;
    const bf16_t* Z; bf16_t* MG;
    __device__ __forceinline__ void mid(f32x4 (&acc)[2][2][4][2], const Unit& u, int wr, int wc, int fr, int fq) const {
        int row0 = u.pm * 256 + wr * 64 + fr, col0 = u.pn * 256 + wc * 32 + 8 * fq;
        asm volatile("" : "+v"(row0), "+v"(col0));
#pragma unroll
        for (int ai = 0; ai < 2; ++ai)
#pragma unroll
            for (int m = 0; m < 4; ++m) { const int row = row0 + ai * 128 + m * 16;
#pragma unroll
                for (int bj = 0; bj < 2; ++bj) { float a[8], b[8]; const bf16_t* zp = Z + (size_t)row * INW + 4096 + col0 + bj * 128; unpack8(*(const u32x4*)zp, a); unpack8(*(const u32x4*)(zp + 1024), b);
#pragma unroll
                    for (int j = 0; j < 4; ++j) { acc[ai][bj][m][0][j] *= a[j] * fast_rcp(b[j]); acc[ai][bj][m][1][j] *= a[4 + j] * fast_rcp(b[4 + j]); } }
                asm volatile("" ::: "memory"); }
    }
    __device__ __forceinline__ void operator()(const f32x4 (&acc)[2][2][4][2], const Unit& u, int wr, int wc, int fr, int fq) const {
        const int row0 = u.pm * 256 + wr * 64 + fr, col0 = u.pn * 256 + wc * 32 + 8 * fq;
#pragma unroll
        for (int ai = 0; ai < 2; ++ai)
#pragma unroll
            for (int m = 0; m < 4; ++m) { const int row = row0 + ai * 128 + m * 16;
#pragma unroll
                for (int bj = 0; bj < 2; ++bj) { float b[8]; unpack8(*(const u32x4*)(Z + (size_t)row * INW + 5120 + col0 + bj * 128), b); float v[8];
#pragma unroll
                    for (int j = 0; j < 4; ++j) { v[j] = b[j] * acc[ai][bj][m][0][j]; v[4 + j] = b[4 + j] * acc[ai][bj][m][1][j]; }
                    *(u32x4*)(MG + (size_t)row * DM + col0 + bj * 128) = pack8(v); } }
    }
};
struct EpiOut1 {
    static constexpr bool PERM = true, AFTER_DRAIN = false, MID = false;
    const float* xs; float* outs; bf16_t* P1B; float* st1;
    __device__ __forceinline__ void operator()(const f32x4 (&acc)[2][2][4][2], const Unit& u, int wr, int wc, int fr, int fq) const {
        const int row0 = u.pm * 256 + wr * 64 + fr, col0 = u.pn * 256 + wc * 32 + 8 * fq;
#pragma unroll
        for (int ai = 0; ai < 2; ++ai)
#pragma unroll
            for (int m = 0; m < 4; ++m) { const int row = row0 + ai * 128 + m * 16; float s = 0.f, q = 0.f;
#pragma unroll
                for (int bj = 0; bj < 2; ++bj) { const size_t off = (size_t)row * DM + col0 + bj * 128; const f32x4 x0 = *(const f32x4*)(xs + off), x1 = *(const f32x4*)(xs + off + 4);
                    const f32x4 p0 = x0 * ALPHA + acc[ai][bj][m][0], p1 = x1 * ALPHA + acc[ai][bj][m][1]; float v[8];
#pragma unroll
                    for (int j = 0; j < 4; ++j) { v[j] = p0[j]; v[4 + j] = p1[j]; s += p0[j] + p1[j]; q += p0[j] * p0[j] + p1[j] * p1[j]; }
                    *(f32x4*)(outs + off) = p0; *(f32x4*)(outs + off + 4) = p1; *(u32x4*)(P1B + off) = pack8(v); }
                put_stat(st1, row, u.pn * 4 + wc, s, q, fq); }
    }
};
struct EpiUp {
    static constexpr bool PERM = true, AFTER_DRAIN = false, MID = false;
    bf16_t* HUP; const float* st1; const float* colsum; const float* bW;
    __device__ __forceinline__ void operator()(const f32x4 (&acc)[2][2][4][2], const Unit& u, int wr, int wc, int fr, int fq) const {
        const int row0 = u.pm * 256 + wr * 64 + fr, col0 = u.pn * 256 + wc * 32 + 8 * fq;
        f32x4 cs[2][2], bw[2][2];
#pragma unroll
        for (int bj = 0; bj < 2; ++bj)
#pragma unroll
            for (int n = 0; n < 2; ++n) { cs[bj][n] = *(const f32x4*)(colsum + col0 + bj * 128 + 4 * n); bw[bj][n] = *(const f32x4*)(bW + col0 + bj * 128 + 4 * n); }
#pragma unroll
        for (int ai = 0; ai < 2; ++ai)
#pragma unroll
            for (int m = 0; m < 4; ++m) { const int row = row0 + ai * 128 + m * 16; const f32x2v mr = get_stat(st1, row, fq);
#pragma unroll
                for (int bj = 0; bj < 2; ++bj) { const f32x4 h0 = (acc[ai][bj][m][0] - cs[bj][0] * mr.x) * mr.y + bw[bj][0], h1 = (acc[ai][bj][m][1] - cs[bj][1] * mr.x) * mr.y + bw[bj][1];
                    u32x4 w; w.x = cvt_pk_bf16(h0[0], h0[1]); w.y = cvt_pk_bf16(h0[2], h0[3]); w.z = cvt_pk_bf16(h1[0], h1[1]); w.w = cvt_pk_bf16(h1[2], h1[3]);
                    *(u32x4*)(HUP + (size_t)row * INW + col0 + bj * 128) = w; } }
    }
};
struct EpiDown {
    static constexpr bool PERM = true, AFTER_DRAIN = false, MID = false;
    float* outs; const float* st1; float* st2; const float* g1; const float* b1;
    __device__ __forceinline__ void operator()(const f32x4 (&acc)[2][2][4][2], const Unit& u, int wr, int wc, int fr, int fq) const {
        const int row0 = u.pm * 256 + wr * 64 + fr, col0 = u.pn * 256 + wc * 32 + 8 * fq;
        f32x4 gg[2][2], bb[2][2];
#pragma unroll
        for (int bj = 0; bj < 2; ++bj)
#pragma unroll
            for (int n = 0; n < 2; ++n) { gg[bj][n] = *(const f32x4*)(g1 + col0 + bj * 128 + 4 * n) * ALPHA; bb[bj][n] = *(const f32x4*)(b1 + col0 + bj * 128 + 4 * n) * ALPHA; }
#pragma unroll
        for (int ai = 0; ai < 2; ++ai)
#pragma unroll
            for (int m = 0; m < 4; ++m) { const int row = row0 + ai * 128 + m * 16; const f32x2v mr = get_stat(st1, row, fq); float s = 0.f, q = 0.f;
#pragma unroll
                for (int bj = 0; bj < 2; ++bj) { float* o = outs + (size_t)row * DM + col0 + bj * 128; const f32x4 x0 = *(const f32x4*)o, x1 = *(const f32x4*)(o + 4);
                    const f32x4 p0 = (x0 - mr.x) * mr.y * gg[bj][0] + bb[bj][0] + acc[ai][bj][m][0], p1 = (x1 - mr.x) * mr.y * gg[bj][1] + bb[bj][1] + acc[ai][bj][m][1];
#pragma unroll
                    for (int j = 0; j < 4; ++j) { s += p0[j] + p1[j]; q += p0[j] * p0[j] + p1[j] * p1[j]; }
                    *(f32x4*)o = p0; *(f32x4*)(o + 4) = p1; }
                put_stat(st2, row, u.pn * 4 + wc, s, q, fq); }
    }
};

struct Ctx {
    Params p;
    __device__ __forceinline__ const float* in(int i) const { return p.in[i]; }
    __device__ __forceinline__ float* out() const { return p.out; }
#define WSP(name, type, off) __device__ __forceinline__ type* name() const { return (type*)(p.ws + (off)); }
    WSP(WinT, bf16_t, WS_WIN) WSP(WupT, bf16_t, WS_WUP) WSP(WdT, bf16_t, WS_WD) WSP(PaT, bf16_t, WS_PA) WSP(PbT, bf16_t, WS_PB) WSP(WoT, bf16_t, WS_WO) WSP(WG, bf16_t, WS_WG) WSP(WS, bf16_t, WS_WS)
    WSP(XB, bf16_t, WS_XB) WSP(Z, bf16_t, WS_Z) WSP(YA, bf16_t, WS_YA) WSP(YB, bf16_t, WS_YB) WSP(MG, bf16_t, WS_MG) WSP(ACT, bf16_t, WS_TMP)
    WSP(cfac, float, WS_CFAC) WSP(colsum, float, WS_COLSUM) WSP(bW, float, WS_BW) WSP(vst, float, WS_VST) WSP(st1, float, WS_ST1) WSP(st2, float, WS_ST2) WSP(sum, float, WS_SUM) WSP(TMP, float, WS_TMP)
#undef WSP
};
__device__ __forceinline__ const float* slab_x(const Ctx& X, int s) { return s < 2 ? X.in(0) + (size_t)s * TS * DM : X.in(1) + (size_t)(s - 2) * TS * DM; }
__device__ __forceinline__ float* slab_out(const Ctx& X, int s) { return X.out() + (size_t)s * TS * DM; }
__device__ __forceinline__ int slab_seqlen(int s) { return s < 2 ? 2048 : 16384; }

__device__ __forceinline__ void grid_barrier(unsigned* cnt, unsigned& target) {
    asm volatile("s_waitcnt vmcnt(0) lgkmcnt(0)" ::: "memory");
    __syncthreads();
    target += gridDim.x;
    if (threadIdx.x == 0) {
        __builtin_amdgcn_fence(__ATOMIC_RELEASE, "agent");
        asm volatile("s_waitcnt vmcnt(0)" ::: "memory");
        __hip_atomic_fetch_add(cnt, 1u, __ATOMIC_RELAXED, __HIP_MEMORY_SCOPE_AGENT);
        while (__hip_atomic_load(cnt, __ATOMIC_RELAXED, __HIP_MEMORY_SCOPE_AGENT) < target) __builtin_amdgcn_s_sleep(1);
        __builtin_amdgcn_fence(__ATOMIC_ACQUIRE, "agent");
        asm volatile("s_waitcnt vmcnt(0)" ::: "memory");
    }
    __syncthreads();
}

__device__ __forceinline__ void transpose_tile(const float* src, bf16_t* dst, int K, int N, int k0, int n0, const float* scale, LAS float* tile, int ldd = 0, int koff = 0) {
    if (ldd == 0) ldd = K;
    int tid = threadIdx.x; asm volatile("" : "+v"(tid));
#pragma unroll
    for (int i = 0; i < 8; ++i) { const int idx = tid + NTHR * i, r = idx >> 6, c = idx & 63; float v = src[(size_t)(k0 + r) * N + n0 + c]; if (scale) v *= scale[k0 + r]; tile[r * 65 + c] = v; }
    __syncthreads();
#pragma unroll
    for (int i = 0; i < 4; ++i) { const int idx = tid + NTHR * i, r = idx >> 5, c2 = idx & 31;
        *(unsigned*)(dst + (size_t)(n0 + r) * ldd + koff + k0 + 2 * c2) = cvt_pk_bf16(tile[(2 * c2) * 65 + r], tile[(2 * c2 + 1) * 65 + r]); }
    __syncthreads();
}
__device__ __forceinline__ void convert_x(const float* xs, bf16_t* XB) {
    int tid = threadIdx.x; asm volatile("" : "+v"(tid));
    const size_t gtid = (size_t)blockIdx.x * NTHR + tid, gth = (size_t)gridDim.x * NTHR;
    for (size_t g = gtid; g < (size_t)TS * DM / 8; g += gth) { const f32x4 a = ((const f32x4*)xs)[2 * g], b = ((const f32x4*)xs)[2 * g + 1];
        u32x4 w; w.x = cvt_pk_bf16(a[0], a[1]); w.y = cvt_pk_bf16(a[2], a[3]); w.z = cvt_pk_bf16(b[0], b[1]); w.w = cvt_pk_bf16(b[2], b[3]); ((u32x4*)XB)[g] = w; }
}
__device__ __forceinline__ void phase_prep(const Ctx& X, LAS unsigned char* lds) {
    LAS float* tile = (LAS float*)lds;
    int tid = threadIdx.x; asm volatile("" : "+v"(tid));
    for (int t = blockIdx.x; t < 4736; t += gridDim.x) {
        if (t < 1536) { transpose_tile(X.in(2), X.WinT(), 1024, 6144, (t / 96) * 64, (t % 96) * 64, nullptr, tile); }
        else if (t < 3072) { const int u = t - 1536; transpose_tile(X.in(19), X.WupT(), 1024, 6144, (u / 96) * 64, (u % 96) * 64, X.in(17), tile); }
        else if (t < 3840) { const int u = t - 3072; transpose_tile(X.in(22), X.WdT(), 3072, 1024, (u / 16) * 64, (u % 16) * 64, nullptr, tile); }
        else if (t < 4096) { const int v = t - 3840; transpose_tile(X.in(14), X.PaT(), 1024, 1024, (v / 16) * 64, (v % 16) * 64, nullptr, tile, 2048, 0); }
        else if (t < 4352) { const int v = t - 4096; transpose_tile(X.in(15), X.PaT(), 1024, 1024, (v / 16) * 64, (v % 16) * 64, nullptr, tile, 2048, 1024); }
        else if (t < 4608) { const int v = t - 4352; transpose_tile(X.in(16), X.WoT(), 1024, 1024, (v / 16) * 64, (v % 16) * 64, nullptr, tile); }
        else { const int u = t - 4608, mat = u >> 2, q = u & 3, type = mat >> 4, dh = mat & 15;
            const int dir = dh >> 3, h = dh & 7;
            if (type == 0) transpose_tile(X.in(5) + (size_t)dh * 16384, X.WG() + (size_t)((dir * 2 + 0) * 8 + h) * 16384, 128, 128, (q >> 1) * 64, (q & 1) * 64, nullptr, tile);
            else transpose_tile(X.in(7) + (size_t)dh * 16384, X.WG() + (size_t)((dir * 2 + 1) * 8 + h) * 16384, 128, 128, (q >> 1) * 64, (q & 1) * 64, nullptr, tile); }
    }
    const size_t gtid = (size_t)blockIdx.x * NTHR + tid, gth = (size_t)gridDim.x * NTHR;
    for (size_t i = gtid; i < 8 * 16384; i += gth) { const float v = X.in(12)[i]; unsigned u = __float_as_uint(v); u += 0x7FFFu + ((u >> 16) & 1u); X.WS()[i] = (bf16_t)(u >> 16); }
    for (size_t i = gtid; i < 2048; i += gth) { const float nl = -X.in(9)[i]; const float sp = nl > 15.f ? nl : log1pf(__expf(nl)); X.cfac()[i] = -8.0f * sp; }
    for (int u = blockIdx.x; u < 96; u += gridDim.x) { const int n = u * 64 + (tid & 63), kg = tid >> 6; float s = 0.f;
#pragma unroll 8
        for (int k = kg; k < 1024; k += 8) s += X.in(18)[k] * X.in(19)[(size_t)k * 6144 + n];
        tile[kg * 64 + (tid & 63)] = s; __syncthreads();
        if (tid < 64) { float t = 0.f;
#pragma unroll
            for (int j = 0; j < 8; ++j) t += tile[j * 64 + tid]; X.bW()[n] = t; }
        __syncthreads(); }
    convert_x(slab_x(X, 0), X.XB());
}
__device__ __forceinline__ void colsum_job(const Ctx& X) {
    int tid = threadIdx.x; asm volatile("" : "+v"(tid));
    const int lane = tid & 63, gw = blockIdx.x * 8 + (tid >> 6), nw = gridDim.x * 8;
    for (int n = gw; n < 6144; n += nw) { const u32x4* p = (const u32x4*)(X.WupT() + (size_t)n * 1024) + lane * 2; float f[8], s = 0.f;
        unpack8(p[0], f);
#pragma unroll
        for (int j = 0; j < 8; ++j) s += f[j];
        unpack8(p[1], f);
#pragma unroll
        for (int j = 0; j < 8; ++j) s += f[j];
#pragma unroll
        for (int o = 32; o >= 1; o >>= 1) s += __shfl_xor(s, o);
        if (lane == 0) X.colsum()[n] = s; }
}

constexpr int XCF_LD = 132, XCB_LD = 136, XCB_OFF = 128 * XCF_LD * 4, CARRY_OFF = XCB_OFF + 128 * XCB_LD * 2;
template <int PASS, int DIR>
__device__ __forceinline__ void lru_dir(const Ctx& X, int c, int h, LAS unsigned char* lds, float (&hsum)[8][4]) {
    int tid = threadIdx.x; asm volatile("" : "+v"(tid)); const int lane = tid & 63, w = tid >> 6, fr = lane & 15, fq = lane >> 4;
    LAS float* XCF = (LAS float*)lds; LAS bf16_t* XCB = (LAS bf16_t*)(lds + XCB_OFF); LAS float* CARRY = (LAS float*)(lds + CARRY_OFF);
    const bf16_t* WgR = X.WG() + (size_t)((DIR * 2 + 0) * 8 + h) * 16384; const bf16_t* WgI = X.WG() + (size_t)((DIR * 2 + 1) * 8 + h) * 16384;
    bf16x8 BR[4], BI[4];
#pragma unroll
    for (int ks = 0; ks < 4; ++ks) { BR[ks] = *(const bf16x8*)(WgR + (16 * w + fr) * 128 + 32 * ks + 8 * fq); BI[ks] = *(const bf16x8*)(WgI + (16 * w + fr) * 128 + 32 * ks + 8 * fq); }
    const int ch = h * 128 + 16 * w + fr;
    const float ba = X.in(6)[DIR * 1024 + ch], bx = X.in(8)[DIR * 1024 + ch], cf2 = X.cfac()[DIR * 1024 + ch] * 1.4426950408889634f;
    float av[8][4], bv[8][4];
#pragma unroll
    for (int m = 0; m < 8; ++m) { f32x4 aR = {ba, ba, ba, ba}, aI = {bx, bx, bx, bx};
#pragma unroll
        for (int ks = 0; ks < 4; ++ks) { const bf16x8 a = *(const LAS bf16x8*)(XCB + (16 * m + fr) * XCB_LD + 32 * ks + 8 * fq);
            aR = __builtin_amdgcn_mfma_f32_16x16x32_bf16(a, BR[ks], aR, 0, 0, 0); aI = __builtin_amdgcn_mfma_f32_16x16x32_bf16(a, BI[ks], aI, 0, 0, 0); }
#pragma unroll
        for (int r = 0; r < 4; ++r) { const float rg = sigmoid_f(aR[r]), ig = sigmoid_f(aI[r]), a = __builtin_amdgcn_exp2f(cf2 * rg), om = 1.f - a * a;
            const float xc = XCF[(16 * m + 4 * fq + r) * XCF_LD + 16 * w + fr];
            av[m][r] = a; bv[m][r] = __builtin_amdgcn_sqrtf(om) * ig * xc; }
        __builtin_amdgcn_sched_barrier(0); }
    float carry = 0.f, CA = 1.f, CB = 0.f;
    if (PASS == 2) carry = CARRY[DIR * 128 + 16 * w + fr];
#pragma unroll
    for (int mm = 0; mm < 8; ++mm) { const int m = DIR == 0 ? mm : 7 - mm;
        float A, B;
        if (DIR == 0) { A = av[m][0]; B = bv[m][0];
#pragma unroll
            for (int r = 1; r < 4; ++r) { B = av[m][r] * B + bv[m][r]; A *= av[m][r]; } }
        else { A = av[m][3]; B = bv[m][3];
#pragma unroll
            for (int r = 2; r >= 0; --r) { B = av[m][r] * B + bv[m][r]; A *= av[m][r]; } }
        { const float A1 = DIR == 0 ? __shfl_up(A, 16) : __shfl_down(A, 16), B1 = DIR == 0 ? __shfl_up(B, 16) : __shfl_down(B, 16);
          if (DIR == 0 ? fq >= 1 : fq <= 2) { B = A * B1 + B; A = A1 * A; } }
        { const float A2 = DIR == 0 ? __shfl_up(A, 32) : __shfl_down(A, 32), B2 = DIR == 0 ? __shfl_up(B, 32) : __shfl_down(B, 32);
          if (DIR == 0 ? fq >= 2 : fq <= 1) { B = A * B2 + B; A = A2 * A; } }
        const float TA = __shfl(A, (DIR == 0 ? 48 : 0) + fr), TB = __shfl(B, (DIR == 0 ? 48 : 0) + fr);
        if (PASS == 1) { CB = TA * CB + TB; CA *= TA; }
        else {
            float EA = DIR == 0 ? __shfl_up(A, 16) : __shfl_down(A, 16), EB = DIR == 0 ? __shfl_up(B, 16) : __shfl_down(B, 16);
            if (DIR == 0 ? fq == 0 : fq == 3) { EA = 1.f; EB = 0.f; }
            float hc = EA * carry + EB;
            if (DIR == 0) {
#pragma unroll
                for (int r = 0; r < 4; ++r) { hc = av[m][r] * hc + bv[m][r]; hsum[m][r] += hc; } }
            else {
#pragma unroll
                for (int r = 3; r >= 0; --r) { hc = av[m][r] * hc + bv[m][r]; hsum[m][r] += hc; } }
            carry = TA * carry + TB;
        }
    }
    if (PASS == 1 && fq == 0) { X.sum()[(size_t)((c * 2 + DIR) * 2 + 0) * 1024 + ch] = CA; X.sum()[(size_t)((c * 2 + DIR) * 2 + 1) * 1024 + ch] = CB; }
}
template <int PASS>
__device__ __forceinline__ void lru_job(const Ctx& X, int s, int c, int h, LAS unsigned char* lds) {
    int tid = threadIdx.x; asm volatile("" : "+v"(tid));
    LAS float* XCF = (LAS float*)lds; LAS bf16_t* XCB = (LAS bf16_t*)(lds + XCB_OFF); LAS float* CARRY = (LAS float*)(lds + CARRY_OFF);
    const int L = slab_seqlen(s), t0 = c * 128, sb = (t0 / L) * L, se = sb + L;
    const int cg8 = tid & 15, rg = tid >> 4, ch0 = h * 128 + cg8 * 8;
    {
        float cw[4][8], cb[8];
#pragma unroll
        for (int k = 0; k < 4; ++k) { const f32x4 a = *(const f32x4*)(X.in(3) + k * 1024 + ch0), b = *(const f32x4*)(X.in(3) + k * 1024 + ch0 + 4);
#pragma unroll
            for (int j = 0; j < 4; ++j) { cw[k][j] = a[j]; cw[k][4 + j] = b[j]; } }
        { const f32x4 a = *(const f32x4*)(X.in(4) + ch0), b = *(const f32x4*)(X.in(4) + ch0 + 4);
#pragma unroll
          for (int j = 0; j < 4; ++j) { cb[j] = a[j]; cb[4 + j] = b[j]; } }
        float xin[7][8];
#pragma unroll
        for (int j = 0; j < 7; ++j) { const int t = t0 + 4 * rg - 2 + j; u32x4 wv = {0u, 0u, 0u, 0u};
            if (t >= sb && t < se) wv = *(const u32x4*)(X.Z() + (size_t)t * INW + 1024 + ch0);
            unpack8(wv, xin[j]); }
#pragma unroll
        for (int r = 0; r < 4; ++r) { float v[8];
#pragma unroll
            for (int e = 0; e < 8; ++e) v[e] = cb[e] + cw[0][e] * xin[r][e] + cw[1][e] * xin[r + 1][e] + cw[2][e] * xin[r + 2][e] + cw[3][e] * xin[r + 3][e];
            LAS float* o = XCF + (4 * rg + r) * XCF_LD + cg8 * 8;
            *(LAS f32x4*)o = (f32x4){v[0], v[1], v[2], v[3]}; *(LAS f32x4*)(o + 4) = (f32x4){v[4], v[5], v[6], v[7]};
            *(LAS u32x4*)(XCB + (4 * rg + r) * XCB_LD + cg8 * 8) = pack8(v); }
    }
    if (PASS == 2) {
        const int dir = (tid >> 7) & 1, half = tid >> 8, chn = h * 128 + (tid & 127), c_first = sb / 128, c_last = se / 128 - 1;
        const int n = dir == 0 ? c - c_first : c_last - c, n0 = half == 0 ? 0 : n / 2, n1 = half == 0 ? n / 2 : n;
        float PA = 1.f, PB = 0.f;
#pragma unroll 8
        for (int i = n0; i < n1; ++i) { const int cc = dir == 0 ? c_first + i : c_last - i;
            const float A = X.sum()[(size_t)((cc * 2 + dir) * 2 + 0) * 1024 + chn], Bv = X.sum()[(size_t)((cc * 2 + dir) * 2 + 1) * 1024 + chn]; PB = A * PB + Bv; PA *= A; }
        LAS float* CP = CARRY + 256;
        CP[(half * 256 + (tid & 255)) * 2] = PA; CP[(half * 256 + (tid & 255)) * 2 + 1] = PB;
    }
    __syncthreads();
    if (PASS == 2 && tid < 256) { LAS float* CP = CARRY + 256; const float B0 = CP[tid * 2 + 1], A1 = CP[(256 + tid) * 2], B1 = CP[(256 + tid) * 2 + 1]; CARRY[tid] = A1 * B0 + B1; }
    if (PASS == 2) __syncthreads();
    __syncthreads();
    float hsum[8][4];
#pragma unroll
    for (int m = 0; m < 8; ++m)
#pragma unroll
        for (int r = 0; r < 4; ++r) hsum[m][r] = 0.f;
    __builtin_amdgcn_sched_barrier(0);
    lru_dir<PASS, 0>(X, c, h, lds, hsum);
    __builtin_amdgcn_sched_barrier(0);
    lru_dir<PASS, 1>(X, c, h, lds, hsum);
    __builtin_amdgcn_sched_barrier(0);
    if (PASS == 2) {
        const int lane = tid & 63, w = tid >> 6, fr = lane & 15, fq = lane >> 4;
#pragma unroll
        for (int m = 0; m < 8; ++m)
#pragma unroll
            for (int r = 0; r < 4; ++r) XCF[(16 * m + 4 * fq + r) * XCF_LD + 16 * w + fr] = hsum[m][r];
        __syncthreads();
#pragma unroll
        for (int r = 0; r < 4; ++r) { const int tok = 4 * rg + r; LAS const float* y = XCF + tok * XCF_LD + cg8 * 8; const f32x4 y0 = *(LAS const f32x4*)y, y1 = *(LAS const f32x4*)(y + 4);
            float g[8]; unpack8(*(const u32x4*)(X.Z() + (size_t)(t0 + tok) * INW + ch0), g);
            float v[8];
#pragma unroll
            for (int j = 0; j < 4; ++j) { v[j] = y0[j] * g[j]; v[4 + j] = y1[j] * g[4 + j]; }
            *(u32x4*)(X.YA() + (size_t)(t0 + tok) * 2048 + ch0) = pack8(v); }
    }
    __syncthreads();
}

__device__ __forceinline__ int vt_off(int d, int q) { return d * 136 + (((q >> 3) ^ ((d >> 3) & 15)) << 3) + (q & 7); }
__device__ __forceinline__ void gmlp_job(const Ctx& X, int c, int g, LAS unsigned char* lds) {
    int tid = threadIdx.x; asm volatile("" : "+v"(tid)); const int lane = tid & 63, w = tid >> 6, fr = lane & 15, fq = lane >> 4;
    LAS float* SV = (LAS float*)lds; LAS bf16_t* VT = (LAS bf16_t*)(lds + XCB_OFF); LAS float* MU = (LAS float*)(lds + CARRY_OFF);
    const int t0 = c * 128, cg8 = tid & 15, rg = tid >> 4, ch0 = g * 128 + cg8 * 8;
    if (tid < 128) { const float* p = X.vst() + (size_t)(t0 + tid) * 32; float s = 0.f, q = 0.f;
#pragma unroll
        for (int i = 0; i < 8; ++i) { const f32x4 a = *(const f32x4*)(p + 4 * i); s += a[0] + a[2]; q += a[1] + a[3]; }
        const float mean = s * (1.f / 1024.f), var = q * (1.f / 1024.f) - mean * mean; MU[tid * 2] = mean; MU[tid * 2 + 1] = rsqrtf(var + LN_EPS); }
    bf16x8 Aw[4];
#pragma unroll
    for (int ks = 0; ks < 4; ++ks) Aw[ks] = *(const bf16x8*)(X.WS() + (size_t)g * 16384 + (16 * w + fr) * 128 + 32 * ks + 8 * fq);
    __syncthreads();
    {
        float lg[8], lb[8], vn[4][8];
        { const f32x4 a = *(const f32x4*)(X.in(10) + ch0), b = *(const f32x4*)(X.in(10) + ch0 + 4), cc = *(const f32x4*)(X.in(11) + ch0), d = *(const f32x4*)(X.in(11) + ch0 + 4);
#pragma unroll
          for (int j = 0; j < 4; ++j) { lg[j] = a[j]; lg[4 + j] = b[j]; lb[j] = cc[j]; lb[4 + j] = d[j]; } }
#pragma unroll
        for (int r = 0; r < 4; ++r) { const int tok = 4 * rg + r; float v[8]; unpack8(*(const u32x4*)(X.Z() + (size_t)(t0 + tok) * INW + 3072 + ch0), v);
            const float mean = MU[tok * 2], rstd = MU[tok * 2 + 1];
#pragma unroll
            for (int e = 0; e < 8; ++e) vn[r][e] = (v[e] - mean) * rstd * lg[e] + lb[e]; }
#pragma unroll
        for (int e = 0; e < 8; ++e) { u32x2 pk; pk.x = cvt_pk_bf16(vn[0][e], vn[1][e]); pk.y = cvt_pk_bf16(vn[2][e], vn[3][e]); *(LAS u32x2*)(VT + vt_off(cg8 * 8 + e, 4 * rg)) = pk; }
    }
    __syncthreads();
    f32x4 acc[8];
#pragma unroll
    for (int dt = 0; dt < 8; ++dt) { acc[dt] = (f32x4){0.f, 0.f, 0.f, 0.f};
#pragma unroll
        for (int ks = 0; ks < 4; ++ks) { const bf16x8 b = *(const LAS bf16x8*)(VT + vt_off(16 * dt + fr, 32 * ks + 8 * fq)); acc[dt] = __builtin_amdgcn_mfma_f32_16x16x32_bf16(Aw[ks], b, acc[dt], 0, 0, 0); } }
#pragma unroll
    for (int dt = 0; dt < 8; ++dt)
#pragma unroll
        for (int r = 0; r < 4; ++r) SV[(16 * w + 4 * fq + r) * XCF_LD + 16 * dt + fr] = acc[dt][r];
    __syncthreads();
#pragma unroll
    for (int r = 0; r < 4; ++r) { const int tok = 4 * rg + r; LAS const float* y = SV + tok * XCF_LD + cg8 * 8; const f32x4 y0 = *(LAS const f32x4*)y, y1 = *(LAS const f32x4*)(y + 4);
        float uu[8]; unpack8(*(const u32x4*)(X.Z() + (size_t)(t0 + tok) * INW + 2048 + ch0), uu); const float bsv = X.in(13)[g * 128 + tok];
        float v[8];
#pragma unroll
        for (int j = 0; j < 4; ++j) { v[j] = uu[j] * (y0[j] + bsv); v[4 + j] = uu[4 + j] * (y1[j] + bsv); }
        *(u32x4*)(X.YA() + (size_t)(t0 + tok) * 2048 + 1024 + ch0) = pack8(v); }
    __syncthreads();
}

__device__ __forceinline__ void convgate_phase(const Ctx& X, int s) {
    const bf16_t* HUP = X.Z(); const float* cwp = X.in(20); const float* cbp = X.in(21);
    const int L = slab_seqlen(s);
    int tid = threadIdx.x; asm volatile("" : "+v"(tid));
    const int gtid = blockIdx.x * NTHR + tid, gth = gridDim.x * NTHR;
    for (int item = gtid; item < 2048 * 384; item += gth) { const int rb = item / 384, cgp = item - rb * 384, j0 = cgp * 8, r0 = rb * 8, sb = (r0 / L) * L, se = sb + L;
        u32x4 rg_[10], rv_[10];
#pragma unroll
        for (int i = 0; i < 10; ++i) { const int r = r0 - 1 + i; rg_[i] = (u32x4){0u, 0u, 0u, 0u}; rv_[i] = (u32x4){0u, 0u, 0u, 0u};
            if (r >= sb && r < se) { rg_[i] = *(const u32x4*)(HUP + (size_t)r * INW + j0); rv_[i] = *(const u32x4*)(HUP + (size_t)r * INW + 3072 + j0); } }
        float wg[3][8], wv[3][8], bg[8], bvv[8];
#pragma unroll
        for (int k = 0; k < 3; ++k) { const f32x4 a = *(const f32x4*)(cwp + k * 6144 + j0), b = *(const f32x4*)(cwp + k * 6144 + j0 + 4), c2 = *(const f32x4*)(cwp + k * 6144 + 3072 + j0), d = *(const f32x4*)(cwp + k * 6144 + 3072 + j0 + 4);
#pragma unroll
            for (int j = 0; j < 4; ++j) { wg[k][j] = a[j]; wg[k][4 + j] = b[j]; wv[k][j] = c2[j]; wv[k][4 + j] = d[j]; } }
        { const f32x4 a = *(const f32x4*)(cbp + j0), b = *(const f32x4*)(cbp + j0 + 4), c2 = *(const f32x4*)(cbp + 3072 + j0), d = *(const f32x4*)(cbp + 3072 + j0 + 4);
#pragma unroll
          for (int j = 0; j < 4; ++j) { bg[j] = a[j]; bg[4 + j] = b[j]; bvv[j] = c2[j]; bvv[4 + j] = d[j]; } }
        float pg[8], pv[8], cg_[8], cv[8], ng[8], nv[8];
        unpack8(rg_[0], pg); unpack8(rv_[0], pv); unpack8(rg_[1], cg_); unpack8(rv_[1], cv);
#pragma unroll
        for (int i = 0; i < 8; ++i) { unpack8(rg_[i + 2], ng); unpack8(rv_[i + 2], nv); float o[8];
#pragma unroll
            for (int e = 0; e < 8; ++e) { const float yg = bg[e] + wg[0][e] * pg[e] + wg[1][e] * cg_[e] + wg[2][e] * ng[e], yv = bvv[e] + wv[0][e] * pv[e] + wv[1][e] * cv[e] + wv[2][e] * nv[e];
                o[e] = gelu_f(yg) * yv; pg[e] = cg_[e]; cg_[e] = ng[e]; pv[e] = cv[e]; cv[e] = nv[e]; }
            *(u32x4*)(X.ACT() + (size_t)(r0 + i) * DFF + j0) = pack8(o); }
    }
}
__device__ __forceinline__ void final_ln(const Ctx& X, int s) {
    int tid = threadIdx.x; asm volatile("" : "+v"(tid));
    float* outs = slab_out(X, s); const int lane = tid & 63, gw = blockIdx.x * 8 + (tid >> 6), nw = gridDim.x * 8;
    f32x4 g[4], b[4];
#pragma unroll
    for (int i = 0; i < 4; ++i) { g[i] = *(const f32x4*)(X.in(23) + i * 256 + lane * 4); b[i] = *(const f32x4*)(X.in(24) + i * 256 + lane * 4); }
    for (int row = gw; row < TS; row += nw) { float sv = 0.f, qv = 0.f;
        if (lane < 16) { const f32x2v p = *(const f32x2v*)(X.st2() + ((size_t)row * 16 + lane) * 2); sv = p.x; qv = p.y; }
#pragma unroll
        for (int o = 8; o >= 1; o >>= 1) { sv += __shfl_xor(sv, o); qv += __shfl_xor(qv, o); }
        sv = __shfl(sv, 0); qv = __shfl(qv, 0);
        const float mean = sv * (1.f / 1024.f), rstd = rsqrtf(qv * (1.f / 1024.f) - mean * mean + LN_EPS);
        float* p = outs + (size_t)row * DM + lane * 4;
#pragma unroll
        for (int i = 0; i < 4; ++i) { const f32x4 v = *(const f32x4*)(p + i * 256); *(f32x4*)(p + i * 256) = (v - mean) * rstd * g[i] + b[i]; } }
}

constexpr int N_PHASES = 34;
#ifndef PMASK
#define PMASK 0x3ff
#endif
__global__ void __launch_bounds__(NTHR, 2) mega(Params p) {
    extern __shared__ __attribute__((aligned(16))) unsigned char lds_raw[];
    LAS unsigned char* lds = (LAS unsigned char*)lds_raw;
    cg::grid_group grid = cg::this_grid();
    Ctx X; X.p = p;
    const int G = gridDim.x, bx = blockIdx.x;
    unsigned* bar = (unsigned*)(p.ws + WS_BAR); unsigned bar_target = 0u;
    if (bx == 0 && threadIdx.x == 0) __hip_atomic_store(bar, 0u, __ATOMIC_RELAXED, __HIP_MEMORY_SCOPE_AGENT);
    for (int ph = 0; ph < N_PHASES; ++ph) {
        if (ph == 1) grid.sync(); else if (ph > 1) { if (p.dbl & 0x100) grid_barrier(bar, bar_target); grid_barrier(bar, bar_target); }
        if (ph == 0) { if (PMASK & 0x100) { phase_prep(X, lds); if (p.dbl & 0x200) { __syncthreads(); phase_prep(X, lds); } } continue; }
        if (ph == N_PHASES - 1) { if (PMASK & 0x200) final_ln(X, NSLAB - 1); continue; }
        const int s = (ph - 1) >> 3, k = (ph - 1) & 7;
        const int nrep = (k < 7 && ((p.dbl >> k) & 1)) ? 2 : 1;
        for (int rep = 0; rep < nrep; ++rep) {
        if (k == 0 && (PMASK & 1)) {
            pg8::Gemm g{X.XB(), X.WinT(), TS, INW, DM}; pg8::StaticOrder S; S.init(TS, INW, G, bx); EpiZ E{X.Z(), X.vst()};
            pg8::gemm_phase<EpiZ, pg8::StaticOrder>(lds, g, S, E);
        } else if (k == 1 && (PMASK & 2)) {
            if (rep == 0) { if (s == 0) colsum_job(X); else final_ln(X, s - 1); }
            for (int j = bx; j < 2048; j += G) { const int c = (j >> 3) & 127, h = j & 7; if (j < 1024) lru_job<1>(X, s, c, h, lds); else gmlp_job(X, c, h, lds); }
        } else if (k == 2 && (PMASK & 4)) {
            for (int j = bx; j < 1024; j += G) lru_job<2>(X, s, j >> 3, j & 7, lds);
        } else if (k == 3 && (PMASK & 8)) {
            pg8::Gemm g{X.YA(), X.PaT(), TS, DM, 2048}; pg8::StaticOrder S; S.init(TS, DM, G, bx); EpiProj E{X.Z(), X.MG()}; pg8::gemm_phase<EpiProj, pg8::StaticOrder>(lds, g, S, E);
        } else if (k == 4 && (PMASK & 16)) {
            pg8::Gemm g{X.MG(), X.WoT(), TS, DM, DM}; pg8::StaticOrder S; S.init(TS, DM, G, bx); EpiOut1 E{slab_x(X, s), slab_out(X, s), X.YA(), X.st1()};
            pg8::gemm_phase<EpiOut1, pg8::StaticOrder>(lds, g, S, E);
        } else if (k == 5 && (PMASK & 32)) {
            pg8::Gemm g{X.YA(), X.WupT(), TS, INW, DM}; pg8::StaticOrder S; S.init(TS, INW, G, bx); EpiUp E{X.Z(), X.st1(), X.colsum(), X.bW()};
            pg8::gemm_phase<EpiUp, pg8::StaticOrder>(lds, g, S, E);
        } else if (k == 6 && (PMASK & 64)) {
            convgate_phase(X, s); if (s + 1 < NSLAB) convert_x(slab_x(X, s + 1), X.XB());
        } else if (PMASK & 128) {
            pg8::Gemm g{X.ACT(), X.WdT(), TS, DM, DFF}; pg8::StaticOrder S; S.init(TS, DM, G, bx); EpiDown E{slab_out(X, s), X.st1(), X.st2(), X.in(17), X.in(18)};
            pg8::gemm_phase<EpiDown, pg8::StaticOrder>(lds, g, S, E);
        }
        }
    }
}

extern "C" void kernel_launch(void* const* d_in, const int* in_sizes, int n_in, void* d_out, int out_size, void* d_ws, size_t ws_size, hipStream_t stream) {
    constexpr int LDS_BYTES = pg8::STAGE_BYTES;
    static int grid = 0;
    if (grid == 0) {
        int dev = 0, cus = 0, per_cu = 0;
        if (n_in != 25 || ws_size < WS_BAR + 256) { fprintf(stderr, "kernel_launch: need 25 inputs and %zu bytes of workspace (got %d, %zu)\n", (size_t)WS_BAR + 256, n_in, ws_size); grid = -1; return; }
        (void)hipGetDevice(&dev); (void)hipDeviceGetAttribute(&cus, hipDeviceAttributeMultiprocessorCount, dev);
        (void)hipFuncSetAttribute((const void*)mega, hipFuncAttributeMaxDynamicSharedMemorySize, LDS_BYTES);
        (void)hipOccupancyMaxActiveBlocksPerMultiprocessor(&per_cu, (const void*)mega, NTHR, LDS_BYTES);
        grid = cus;
    }
    if (grid < 0) return;
    Params p{};
    for (int i = 0; i < 25; ++i) p.in[i] = (const float*)d_in[i];
    p.out = (float*)d_out; p.ws = (unsigned char*)d_ws;
#ifdef DBL
    p.dbl = DBL;
#endif
#ifndef MK_SPLIT
    p.ph_lo = 0; p.ph_hi = N_PHASES;
    void* args[] = {&p};
    hipError_t e = hipLaunchCooperativeKernel((const void*)mega, dim3(grid), dim3(NTHR), args, LDS_BYTES, stream);
    if (e != hipSuccess) fprintf(stderr, "cooperative launch failed: %s (grid %d)\n", hipGetErrorString(e), grid);
#else
    for (int ph = 0; ph < N_PHASES; ++ph) { p.ph_lo = ph; p.ph_hi = ph + 1; void* args[] = {&p};
        hipError_t e = hipLaunchCooperativeKernel((const void*)mega, dim3(grid), dim3(NTHR), args, LDS_BYTES, stream);
        if (e != hipSuccess) { fprintf(stderr, "launch %d failed: %s\n", ph, hipGetErrorString(e)); break; } }
#endif
}
```

```cpp
#include <hip/hip_runtime.h>
#include <hip/hip_cooperative_groups.h>
#include <cstdio>
namespace cg = cooperative_groups;
namespace pg8 {
#define PG8_LAS __attribute__((address_space(3)))
typedef unsigned short bf16_t;
typedef short bf16x8 __attribute__((ext_vector_type(8)));
typedef float f32x4 __attribute__((ext_vector_type(4)));
typedef unsigned u32x4 __attribute__((ext_vector_type(4)));
constexpr int BM = 256, BK = 64, HALF = 128, HTB = HALF * BK * 2  , STAGE_BYTES = 8 * HTB, NXCD = 8, WGM = 8;

__host__ __device__ __forceinline__ int lds_byte(int r, int c) { const int st = (r >> 4) * 2 + (c >> 5), rr = r & 15, cc = c & 31, ob = rr * 64 + cc * 2; return st * 1024 + (ob ^ (((ob >> 9) & 1) << 5)); }
__host__ __device__ __forceinline__ void stage_rc(int b, int& R, int& C) { const int st = b / 1024, sb = b % 1024, swz = sb ^ (((sb >> 9) & 1) << 5); R = (st >> 1) * 16 + swz / 64; C = (st & 1) * 32 + (swz % 64) / 2; }
__host__ __device__ __forceinline__ int perm32(int rho) { const int n = rho >> 4, i = rho & 15; return 8 * (i >> 2) + 4 * n + (i & 3); }

struct Unit { int pm, pn; };
struct Gemm { const bf16_t* A; const bf16_t* Bt; int M, N, K; };

struct StaticOrder {
    int nM, nN, nwg, G, c;
    __host__ __device__ void init(int M, int N, int G_, int c_) { nM = M / BM; nN = N / BM; nwg = nM * nN; G = G_; c = c_; }
    __host__ __device__ bool next(int i, Unit& u) const {
        const long L = (long)i * G + c; if (L >= nwg) return false;
        int wgid = (int)L; { const int q = nwg / NXCD, r = nwg % NXCD, xcd = wgid % NXCD, off = wgid / NXCD; wgid = (xcd < r ? xcd * (q + 1) : r * (q + 1) + (xcd - r) * q) + off; }
        const int nig = WGM * nN, gid = wgid / nig, fm = gid * WGM, gsz = (nM - fm) < WGM ? (nM - fm) : WGM;
        u.pm = fm + ((wgid % nig) % gsz); u.pn = (wgid % nig) / gsz; return true;
    }
    __device__ __forceinline__ void a_ready(const Unit&) const {}
    __device__ __forceinline__ void done(const Unit&) const {}
};

__device__ __forceinline__ unsigned cvt_pk_bf16(float lo, float hi) { unsigned r; asm volatile("v_cvt_pk_bf16_f32 %0, %1, %2" : "=v"(r) : "v"(lo), "v"(hi)); return r; }
typedef float f32x2 __attribute__((ext_vector_type(2)));

template <class Epi, class Sched>
__device__ __forceinline__ void gemm_phase(PG8_LAS unsigned char* lds, const Gemm g, const Sched& S, const Epi& E) {
    int tid = threadIdx.x; asm volatile("" : "+v"(tid));
    const int wid = __builtin_amdgcn_readfirstlane(tid >> 6), lane = tid & 63, wr = wid >> 2, wc = wid & 3, fr = lane & 15, fq = lane >> 4;
    const int K = g.K, nt = K / BK;
    unsigned voffA[2], voffB[2];
#pragma unroll
    for (int i = 0; i < 2; ++i) { int R, C; stage_rc(tid * 16 + i * 8192, R, C); const int Rb = Epi::PERM ? ((R & ~31) + perm32(R & 31)) : R;
        voffA[i] = (unsigned)(R * K + C) * 2u; voffB[i] = (unsigned)(Rb * K + C) * 2u; }
    const size_t kstep = (size_t)(BK * 2);
    const size_t hstep = (size_t)HALF * K * 2;
    const size_t tstep = 2 * hstep;
    const unsigned ldsw = (unsigned)wid * 1024u;
    const int aoff = lds_byte(wr * 64 + fr, fq * 8), boff = lds_byte(wc * 32 + fr, fq * 8);
#define PG8_SA(b, h) (((b) * 2 + (h)) * HTB)
#define PG8_SB(b, h) ((4 + (b) * 2 + (h)) * HTB)
#define PG8_STAGE(bufoff, gbase, voff) do { _Pragma("unroll") for (int _i = 0; _i < 2; ++_i) \
        __builtin_amdgcn_global_load_lds((const unsigned*)((const char*)(gbase) + (voff)[_i]), (PG8_LAS unsigned*)(lds + (bufoff) + ldsw + _i * 8192), 16, 0, 0); } while (0)
#define PG8_LDA(dst, b, h) do { _Pragma("unroll") for (int m = 0; m < 4; ++m) _Pragma("unroll") for (int k = 0; k < 2; ++k) dst[m][k] = *(const PG8_LAS bf16x8*)(lds + PG8_SA(b, h) + aoff + m * 2048 + k * 1024); } while (0)
#define PG8_LDB(dst, b, h) do { _Pragma("unroll") for (int n = 0; n < 2; ++n) _Pragma("unroll") for (int k = 0; k < 2; ++k) dst[n][k] = *(const PG8_LAS bf16x8*)(lds + PG8_SB(b, h) + boff + n * 2048 + k * 1024); } while (0)
#define PG8_MMA(ai, bj, At, Bt) do { __builtin_amdgcn_s_setprio(1); _Pragma("unroll") for (int m = 0; m < 4; ++m) _Pragma("unroll") for (int n = 0; n < 2; ++n) _Pragma("unroll") for (int k = 0; k < 2; ++k) \
        acc[ai][bj][m][n] = __builtin_amdgcn_mfma_f32_16x16x32_bf16(Bt[n][k], At[m][k], acc[ai][bj][m][n], 0, 0, 0); __builtin_amdgcn_s_setprio(0); } while (0)
#define PG8_WAIT_V(n) asm volatile("s_waitcnt vmcnt(" #n ")" ::: "memory")
#define PG8_WAIT_L(n) asm volatile("s_waitcnt lgkmcnt(" #n ")" ::: "memory")
#define PG8_BAR __builtin_amdgcn_s_barrier()
#define PG8_SCHED __builtin_amdgcn_sched_barrier(0)
    Unit cur, nxt; int ui = 0;
    if (!S.next(0, cur)) return;
    f32x4 acc[2][2][4][2];
#pragma unroll
    for (int a = 0; a < 2; ++a)
#pragma unroll
        for (int b = 0; b < 2; ++b)
#pragma unroll
            for (int m = 0; m < 4; ++m)
#pragma unroll
                for (int n = 0; n < 2; ++n) acc[a][b][m][n] = (f32x4){0.f, 0.f, 0.f, 0.f};
    bf16x8 At[4][2], B0[2][2], B1[2][2];
    const char* cA = (const char*)g.A + (size_t)cur.pm * tstep; const char* cB = (const char*)g.Bt + (size_t)cur.pn * tstep;
    S.a_ready(cur);
    PG8_STAGE(PG8_SB(0, 0), cB, voffB); PG8_STAGE(PG8_SA(0, 0), cA, voffA); PG8_STAGE(PG8_SB(0, 1), cB + hstep, voffB); PG8_STAGE(PG8_SA(0, 1), cA + hstep, voffA);
    if (wr == 1) PG8_BAR;
    PG8_WAIT_V(4); PG8_BAR;
    PG8_STAGE(PG8_SB(1, 0), cB + kstep, voffB); PG8_STAGE(PG8_SA(1, 0), cA + kstep, voffA); PG8_STAGE(PG8_SB(1, 1), cB + hstep + kstep, voffB);
    PG8_WAIT_V(6); PG8_BAR;
    for (;;) {
        const bool has_next = S.next(ui + 1, nxt);
        const char* nA = has_next ? (const char*)g.A + (size_t)nxt.pm * tstep : cA; const char* nB = has_next ? (const char*)g.Bt + (size_t)nxt.pn * tstep : cB;
        for (int t = 0; t < nt; t += 2) {
            if constexpr (Epi::MID) { if (t == nt / 2) E.mid(acc, cur, wr, wc, fr, fq); }
            const bool last = (t == nt - 2);
            const char* a1 = cA + (size_t)(t + 1) * kstep;
            const char* a2 = last ? nA : cA + (size_t)(t + 2) * kstep; const char* b2 = last ? nB : cB + (size_t)(t + 2) * kstep;
            const char* a3 = a2 + kstep; const char* b3 = b2 + kstep;
            if (last && has_next) S.a_ready(nxt);
            PG8_LDB(B0, 0, 0); PG8_SCHED; PG8_LDA(At, 0, 0); PG8_STAGE(PG8_SA(1, 1), a1 + hstep, voffA);
            PG8_WAIT_L(8); PG8_BAR; PG8_WAIT_L(0); PG8_MMA(0, 0, At, B0); PG8_BAR; PG8_SCHED;
            PG8_LDB(B1, 0, 1); PG8_STAGE(PG8_SB(0, 0), b2, voffB);
            PG8_BAR; PG8_WAIT_L(0); PG8_MMA(0, 1, At, B1); PG8_BAR;
            PG8_LDA(At, 0, 1); PG8_STAGE(PG8_SA(0, 0), a2, voffA);
            PG8_BAR; PG8_WAIT_L(0); PG8_MMA(1, 0, At, B0); PG8_BAR; PG8_SCHED;
            PG8_STAGE(PG8_SB(0, 1), b2 + hstep, voffB);
            PG8_WAIT_V(6); PG8_BAR; PG8_MMA(1, 1, At, B1); PG8_BAR;
            PG8_LDB(B0, 1, 0); PG8_SCHED; PG8_LDA(At, 1, 0); PG8_STAGE(PG8_SA(0, 1), a2 + hstep, voffA);
            PG8_WAIT_L(8); PG8_BAR; PG8_WAIT_L(0); PG8_MMA(0, 0, At, B0); PG8_BAR; PG8_SCHED;
            PG8_LDB(B1, 1, 1); PG8_STAGE(PG8_SB(1, 0), b3, voffB);
            PG8_BAR; PG8_WAIT_L(0); PG8_MMA(0, 1, At, B1); PG8_BAR;
            PG8_LDA(At, 1, 1); PG8_STAGE(PG8_SA(1, 0), a3, voffA);
            PG8_BAR; PG8_WAIT_L(0); PG8_MMA(1, 0, At, B0); PG8_BAR; PG8_SCHED;
            PG8_STAGE(PG8_SB(1, 1), b3 + hstep, voffB);
            PG8_WAIT_V(6); PG8_BAR; PG8_MMA(1, 1, At, B1); PG8_BAR;
        }
        if constexpr (!Epi::AFTER_DRAIN) { E(acc, cur, wr, wc, fr, fq); S.done(cur); }
        if (!has_next) break;
#pragma unroll
        for (int a = 0; a < 2; ++a)
#pragma unroll
            for (int b = 0; b < 2; ++b)
#pragma unroll
                for (int m = 0; m < 4; ++m)
#pragma unroll
                    for (int n = 0; n < 2; ++n) acc[a][b][m][n] = (f32x4){0.f, 0.f, 0.f, 0.f};
        cur = nxt; cA = nA; cB = nB; ++ui;
    }
    PG8_WAIT_V(0);
    if (wr == 0) PG8_BAR;
    PG8_BAR;
    if constexpr (Epi::AFTER_DRAIN) { E.fused(acc, cur, wr, wc, fr, fq, lds, wid, lane); S.done(cur); }
#undef PG8_SA
#undef PG8_SB
#undef PG8_STAGE
#undef PG8_LDA
#undef PG8_LDB
#undef PG8_MMA
#undef PG8_WAIT_V
#undef PG8_WAIT_L
#undef PG8_BAR
#undef PG8_SCHED
}
}

using pg8::bf16_t; using pg8::bf16x8; using pg8::f32x4; using pg8::u32x4; using pg8::Unit; using pg8::cvt_pk_bf16;
typedef unsigned u32x2 __attribute__((ext_vector_type(2)));
typedef float f32x2v __attribute__((ext_vector_type(2)));
#define LAS __attribute__((address_space(3)))
constexpr int DM = 1024, TS = 16384  , NSLAB = 4, INW = 6144, DFF = 3072, NTHR = 512;
constexpr float ALPHA = 1.189207115002721f, LN_EPS = 1e-5f;
constexpr size_t WS_WIN = 0, WS_WUP = WS_WIN + (size_t)INW * DM * 2, WS_WD = WS_WUP + (size_t)INW * DM * 2, WS_PA = WS_WD + (size_t)DM * DFF * 2, WS_PB = WS_PA + (size_t)DM * DM * 2,
    WS_WO = WS_PB + (size_t)DM * DM * 2, WS_WG = WS_WO + (size_t)DM * DM * 2, WS_WS = WS_WG + (size_t)32 * 16384 * 2, WS_CFAC = WS_WS + (size_t)8 * 16384 * 2, WS_COLSUM = WS_CFAC + 8192,
    WS_BW = WS_COLSUM + 24576, WS_VST = WS_BW + 24576, WS_ST1 = WS_VST + (size_t)TS * 128, WS_ST2 = WS_ST1 + (size_t)TS * 128, WS_SUM = WS_ST2 + (size_t)TS * 128,
    WS_XB = WS_SUM + (size_t)128 * 4 * 1024 * 4, WS_Z = WS_XB + (size_t)TS * DM * 2, WS_YA = WS_Z + (size_t)TS * INW * 2, WS_YB = WS_YA + (size_t)TS * DM * 2,
    WS_TMP = WS_YB + (size_t)TS * DM * 2, WS_MG = WS_TMP + (size_t)TS * DM * 4, WS_END = WS_MG + (size_t)TS * DM * 2, WS_BAR = WS_END;

struct Params { const float* in[25]; float* out; unsigned char* ws; };

__device__ __forceinline__ float bflo(unsigned u) { return __uint_as_float(u << 16); }
__device__ __forceinline__ float bfhi(unsigned u) { return __uint_as_float(u & 0xffff0000u); }
__device__ __forceinline__ float fast_rcp(float x) { return __builtin_amdgcn_rcpf(x); }
__device__ __forceinline__ float sigmoid_f(float x) { return fast_rcp(1.f + __builtin_amdgcn_exp2f(x * -1.4426950408889634f)); }
__device__ __forceinline__ float gelu_f(float x) { const float x2 = x * x, p = x2 * -0.10294324f + -2.3022082f; return x * fast_rcp(1.f + __builtin_amdgcn_exp2f(x * p)); }
__device__ __forceinline__ void unpack8(const u32x4 w, float (&f)[8]) { f[0] = bflo(w.x); f[1] = bfhi(w.x); f[2] = bflo(w.y); f[3] = bfhi(w.y); f[4] = bflo(w.z); f[5] = bfhi(w.z); f[6] = bflo(w.w); f[7] = bfhi(w.w); }
__device__ __forceinline__ u32x4 pack8(const float (&f)[8]) { u32x4 w; w.x = cvt_pk_bf16(f[0], f[1]); w.y = cvt_pk_bf16(f[2], f[3]); w.z = cvt_pk_bf16(f[4], f[5]); w.w = cvt_pk_bf16(f[6], f[7]); return w; }

__device__ __forceinline__ void put_stat(float* st, int row, int slot, float s, float q, int fq) {
    s += __shfl_xor(s, 16); s += __shfl_xor(s, 32); q += __shfl_xor(q, 16); q += __shfl_xor(q, 32);
    if (fq == 0) *(f32x2v*)(st + ((size_t)row * 16 + slot) * 2) = (f32x2v){s, q};
}
__device__ __forceinline__ f32x2v get_stat(const float* st, int row, int fq) {
    const f32x4 a = *(const f32x4*)(st + ((size_t)row * 16 + fq * 4) * 2), b = *(const f32x4*)(st + ((size_t)row * 16 + fq * 4 + 2) * 2);
    float s = (a[0] + a[2]) + (b[0] + b[2]), q = (a[1] + a[3]) + (b[1] + b[3]);
    s += __shfl_xor(s, 16); s += __shfl_xor(s, 32); q += __shfl_xor(q, 16); q += __shfl_xor(q, 32);
    const float mean = s * (1.f / 1024.f), var = q * (1.f / 1024.f) - mean * mean;
    return (f32x2v){mean, rsqrtf(var + LN_EPS)};
}

struct EpiZ {
    static constexpr bool PERM = true, AFTER_DRAIN = false, MID = false;
    bf16_t* Z; float* vst;
    __device__ __forceinline__ void operator()(const f32x4 (&acc)[2][2][4][2], const Unit& u, int wr, int wc, int fr, int fq) const {
        const int type = u.pn >> 2, row0 = u.pm * 256 + wr * 64 + fr, col0 = u.pn * 256 + wc * 32 + 8 * fq;
#pragma unroll
        for (int ai = 0; ai < 2; ++ai)
#pragma unroll
            for (int m = 0; m < 4; ++m) { const int row = row0 + ai * 128 + m * 16; float s = 0.f, q = 0.f;
#pragma unroll
                for (int bj = 0; bj < 2; ++bj) { float v[8];
#pragma unroll
                    for (int j = 0; j < 8; ++j) { const float x = acc[ai][bj][m][j >> 2][j & 3]; v[j] = (type == 1) ? x : (type >= 4 ? sigmoid_f(x) : gelu_f(x)); }
                    if (type == 3) {
#pragma unroll
                        for (int j = 0; j < 8; ++j) { s += v[j]; q += v[j] * v[j]; } }
                    *(u32x4*)(Z + (size_t)row * INW + col0 + bj * 128) = pack8(v); }
                if (type == 3) put_stat(vst, row, (u.pn - 12) * 4 + wc, s, q, fq); }
    }
};
struct EpiProj {
    static constexpr bool PERM = true, AFTER_DRAIN = false, MID = true;
    const bf16_t* Z; bf16_t* MG;
    __device__ __forceinline__ void mid(f32x4 (&acc)[2][2][4][2], const Unit& u, int wr, int wc, int fr, int fq) const {
        int row0 = u.pm * 256 + wr * 64 + fr, col0 = u.pn * 256 + wc * 32 + 8 * fq;
        asm volatile("" : "+v"(row0), "+v"(col0));
#pragma unroll
        for (int ai = 0; ai < 2; ++ai)
#pragma unroll
            for (int m = 0; m < 4; ++m) { const int row = row0 + ai * 128 + m * 16;
#pragma unroll
                for (int bj = 0; bj < 2; ++bj) { float a[8], b[8]; const bf16_t* zp = Z + (size_t)row * INW + 4096 + col0 + bj * 128; unpack8(*(const u32x4*)zp, a); unpack8(*(const u32x4*)(zp + 1024), b);
#pragma unroll
                    for (int j = 0; j < 4; ++j) { acc[ai][bj][m][0][j] *= a[j] * fast_rcp(b[j]); acc[ai][bj][m][1][j] *= a[4 + j] * fast_rcp(b[4 + j]); } }
                asm volatile("" ::: "memory"); }
    }
    __device__ __forceinline__ void operator()(const f32x4 (&acc)[2][2][4][2], const Unit& u, int wr, int wc, int fr, int fq) const {
        const int row0 = u.pm * 256 + wr * 64 + fr, col0 = u.pn * 256 + wc * 32 + 8 * fq;
#pragma unroll
        for (int ai = 0; ai < 2; ++ai)
#pragma unroll
            for (int m = 0; m < 4; ++m) { const int row = row0 + ai * 128 + m * 16;
#pragma unroll
                for (int bj = 0; bj < 2; ++bj) { float b[8]; unpack8(*(const u32x4*)(Z + (size_t)row * INW + 5120 + col0 + bj * 128), b); float v[8];
#pragma unroll
                    for (int j = 0; j < 4; ++j) { v[j] = b[j] * acc[ai][bj][m][0][j]; v[4 + j] = b[4 + j] * acc[ai][bj][m][1][j]; }
                    *(u32x4*)(MG + (size_t)row * DM + col0 + bj * 128) = pack8(v); } }
    }
};
struct EpiOut1 {
    static constexpr bool PERM = true, AFTER_DRAIN = false, MID = false;
    const float* xs; float* outs; bf16_t* P1B; float* st1;
    __device__ __forceinline__ void operator()(const f32x4 (&acc)[2][2][4][2], const Unit& u, int wr, int wc, int fr, int fq) const {
        const int row0 = u.pm * 256 + wr * 64 + fr, col0 = u.pn * 256 + wc * 32 + 8 * fq;
#pragma unroll
        for (int ai = 0; ai < 2; ++ai)
#pragma unroll
            for (int m = 0; m < 4; ++m) { const int row = row0 + ai * 128 + m * 16; float s = 0.f, q = 0.f;
#pragma unroll
                for (int bj = 0; bj < 2; ++bj) { const size_t off = (size_t)row * DM + col0 + bj * 128; const f32x4 x0 = *(const f32x4*)(xs + off), x1 = *(const f32x4*)(xs + off + 4);
                    const f32x4 p0 = x0 * ALPHA + acc[ai][bj][m][0], p1 = x1 * ALPHA + acc[ai][bj][m][1]; float v[8];
#pragma unroll
                    for (int j = 0; j < 4; ++j) { v[j] = p0[j]; v[4 + j] = p1[j]; s += p0[j] + p1[j]; q += p0[j] * p0[j] + p1[j] * p1[j]; }
                    *(f32x4*)(outs + off) = p0; *(f32x4*)(outs + off + 4) = p1; *(u32x4*)(P1B + off) = pack8(v); }
                put_stat(st1, row, u.pn * 4 + wc, s, q, fq); }
    }
};
struct EpiUp {
    static constexpr bool PERM = true, AFTER_DRAIN = false, MID = false;
    bf16_t* HUP; const float* st1; const float* colsum; const float* bW;
    __device__ __forceinline__ void operator()(const f32x4 (&acc)[2][2][4][2], const Unit& u, int wr, int wc, int fr, int fq) const {
        const int row0 = u.pm * 256 + wr * 64 + fr, col0 = u.pn * 256 + wc * 32 + 8 * fq;
        f32x4 cs[2][2], bw[2][2];
#pragma unroll
        for (int bj = 0; bj < 2; ++bj)
#pragma unroll
            for (int n = 0; n < 2; ++n) { cs[bj][n] = *(const f32x4*)(colsum + col0 + bj * 128 + 4 * n); bw[bj][n] = *(const f32x4*)(bW + col0 + bj * 128 + 4 * n); }
#pragma unroll
        for (int ai = 0; ai < 2; ++ai)
#pragma unroll
            for (int m = 0; m < 4; ++m) { const int row = row0 + ai * 128 + m * 16; const f32x2v mr = get_stat(st1, row, fq);
#pragma unroll
                for (int bj = 0; bj < 2; ++bj) { const f32x4 h0 = (acc[ai][bj][m][0] - cs[bj][0] * mr.x) * mr.y + bw[bj][0], h1 = (acc[ai][bj][m][1] - cs[bj][1] * mr.x) * mr.y + bw[bj][1];
                    u32x4 w; w.x = cvt_pk_bf16(h0[0], h0[1]); w.y = cvt_pk_bf16(h0[2], h0[3]); w.z = cvt_pk_bf16(h1[0], h1[1]); w.w = cvt_pk_bf16(h1[2], h1[3]);
                    *(u32x4*)(HUP + (size_t)row * INW + col0 + bj * 128) = w; } }
    }
};
struct EpiDown {
    static constexpr bool PERM = true, AFTER_DRAIN = false, MID = false;
    const float* src; float* outs; const float* st1; float* st2; const float* g1; const float* b1;
    __device__ __forceinline__ void operator()(const f32x4 (&acc)[2][2][4][2], const Unit& u, int wr, int wc, int fr, int fq) const {
        const int row0 = u.pm * 256 + wr * 64 + fr, col0 = u.pn * 256 + wc * 32 + 8 * fq;
        f32x4 gg[2][2], bb[2][2];
#pragma unroll
        for (int bj = 0; bj < 2; ++bj)
#pragma unroll
            for (int n = 0; n < 2; ++n) { gg[bj][n] = *(const f32x4*)(g1 + col0 + bj * 128 + 4 * n) * ALPHA; bb[bj][n] = *(const f32x4*)(b1 + col0 + bj * 128 + 4 * n) * ALPHA; }
#pragma unroll
        for (int ai = 0; ai < 2; ++ai)
#pragma unroll
            for (int m = 0; m < 4; ++m) { const int row = row0 + ai * 128 + m * 16; const f32x2v mr = get_stat(st1, row, fq); float s = 0.f, q = 0.f;
#pragma unroll
                for (int bj = 0; bj < 2; ++bj) { const size_t eo = (size_t)row * DM + col0 + bj * 128; float* o = outs + eo; const f32x4 x0 = *(const f32x4*)(src + eo), x1 = *(const f32x4*)(src + eo + 4);
                    const f32x4 p0 = (x0 - mr.x) * mr.y * gg[bj][0] + bb[bj][0] + acc[ai][bj][m][0], p1 = (x1 - mr.x) * mr.y * gg[bj][1] + bb[bj][1] + acc[ai][bj][m][1];
#pragma unroll
                    for (int j = 0; j < 4; ++j) { s += p0[j] + p1[j]; q += p0[j] * p0[j] + p1[j] * p1[j]; }
                    *(f32x4*)o = p0; *(f32x4*)(o + 4) = p1; }
                put_stat(st2, row, u.pn * 4 + wc, s, q, fq); }
    }
};

struct Ctx {
    Params p;
    __device__ __forceinline__ const float* in(int i) const { return p.in[i]; }
    __device__ __forceinline__ float* out() const { return p.out; }
#define WSP(name, type, off) __device__ __forceinline__ type* name() const { return (type*)(p.ws + (off)); }
    WSP(WinT, bf16_t, WS_WIN) WSP(WupT, bf16_t, WS_WUP) WSP(WdT, bf16_t, WS_WD) WSP(PaT, bf16_t, WS_PA) WSP(PbT, bf16_t, WS_PB) WSP(WoT, bf16_t, WS_WO) WSP(WG, bf16_t, WS_WG) WSP(WS, bf16_t, WS_WS)
    WSP(XB, bf16_t, WS_XB) WSP(Z, bf16_t, WS_Z) WSP(YA, bf16_t, WS_YA) WSP(YB, bf16_t, WS_YB) WSP(MG, bf16_t, WS_MG) WSP(ACT, bf16_t, WS_TMP)
    WSP(cfac, float, WS_CFAC) WSP(colsum, float, WS_COLSUM) WSP(bW, float, WS_BW) WSP(vst, float, WS_VST) WSP(st1, float, WS_ST1) WSP(st2, float, WS_ST2) WSP(sum, float, WS_SUM) WSP(TMP, float, WS_TMP)
#undef WSP
};
__device__ __forceinline__ const float* slab_x(const Ctx& X, int s) { return s < 2 ? X.in(0) + (size_t)s * TS * DM : X.in(1) + (size_t)(s - 2) * TS * DM; }
__device__ __forceinline__ float* slab_out(const Ctx& X, int s) { return X.out() + (size_t)s * TS * DM; }
__device__ __forceinline__ int slab_seqlen(int s) { return s < 2 ? 2048 : 16384; }

__device__ __forceinline__ void grid_barrier(unsigned* cnt, unsigned& target) {
    asm volatile("s_waitcnt vmcnt(0) lgkmcnt(0)" ::: "memory");
    __syncthreads();
    target += gridDim.x;
    if (threadIdx.x == 0) {
        __builtin_amdgcn_fence(__ATOMIC_RELEASE, "agent");
        asm volatile("s_waitcnt vmcnt(0)" ::: "memory");
        __hip_atomic_fetch_add(cnt, 1u, __ATOMIC_RELAXED, __HIP_MEMORY_SCOPE_AGENT);
        while (__hip_atomic_load(cnt, __ATOMIC_RELAXED, __HIP_MEMORY_SCOPE_AGENT) < target) __builtin_amdgcn_s_sleep(1);
        __builtin_amdgcn_fence(__ATOMIC_ACQUIRE, "agent");
        asm volatile("s_waitcnt vmcnt(0)" ::: "memory");
    }
    __syncthreads();
}

__device__ __forceinline__ void transpose_tile(const float* src, bf16_t* dst, int K, int N, int k0, int n0, const float* scale, LAS float* tile, int ldd = 0, int koff = 0) {
    if (ldd == 0) ldd = K;
    int tid = threadIdx.x; asm volatile("" : "+v"(tid));
#pragma unroll
    for (int i = 0; i < 8; ++i) { const int idx = tid + NTHR * i, r = idx >> 6, c = idx & 63; float v = src[(size_t)(k0 + r) * N + n0 + c]; if (scale) v *= scale[k0 + r]; tile[r * 65 + c] = v; }
    __syncthreads();
#pragma unroll
    for (int i = 0; i < 4; ++i) { const int idx = tid + NTHR * i, r = idx >> 5, c2 = idx & 31;
        *(unsigned*)(dst + (size_t)(n0 + r) * ldd + koff + k0 + 2 * c2) = cvt_pk_bf16(tile[(2 * c2) * 65 + r], tile[(2 * c2 + 1) * 65 + r]); }
    __syncthreads();
}
__device__ __forceinline__ void convert_x(const float* xs, bf16_t* XB) {
    int tid = threadIdx.x; asm volatile("" : "+v"(tid));
    const size_t gtid = (size_t)blockIdx.x * NTHR + tid, gth = (size_t)gridDim.x * NTHR;
    for (size_t g = gtid; g < (size_t)TS * DM / 8; g += gth) { const f32x4 a = ((const f32x4*)xs)[2 * g], b = ((const f32x4*)xs)[2 * g + 1];
        u32x4 w; w.x = cvt_pk_bf16(a[0], a[1]); w.y = cvt_pk_bf16(a[2], a[3]); w.z = cvt_pk_bf16(b[0], b[1]); w.w = cvt_pk_bf16(b[2], b[3]); ((u32x4*)XB)[g] = w; }
}
__device__ __forceinline__ void phase_prep(const Ctx& X, LAS unsigned char* lds) {
    LAS float* tile = (LAS float*)lds;
    int tid = threadIdx.x; asm volatile("" : "+v"(tid));
    for (int t = blockIdx.x; t < 4736; t += gridDim.x) {
        if (t < 1536) { transpose_tile(X.in(2), X.WinT(), 1024, 6144, (t / 96) * 64, (t % 96) * 64, nullptr, tile); }
        else if (t < 3072) { const int u = t - 1536; transpose_tile(X.in(19), X.WupT(), 1024, 6144, (u / 96) * 64, (u % 96) * 64, X.in(17), tile); }
        else if (t < 3840) { const int u = t - 3072; transpose_tile(X.in(22), X.WdT(), 3072, 1024, (u / 16) * 64, (u % 16) * 64, nullptr, tile); }
        else if (t < 4096) { const int v = t - 3840; transpose_tile(X.in(14), X.PaT(), 1024, 1024, (v / 16) * 64, (v % 16) * 64, nullptr, tile, 2048, 0); }
        else if (t < 4352) { const int v = t - 4096; transpose_tile(X.in(15), X.PaT(), 1024, 1024, (v / 16) * 64, (v % 16) * 64, nullptr, tile, 2048, 1024); }
        else if (t < 4608) { const int v = t - 4352; transpose_tile(X.in(16), X.WoT(), 1024, 1024, (v / 16) * 64, (v % 16) * 64, nullptr, tile); }
        else { const int u = t - 4608, mat = u >> 2, q = u & 3, type = mat >> 4, dh = mat & 15;
            const int dir = dh >> 3, h = dh & 7;
            if (type == 0) transpose_tile(X.in(5) + (size_t)dh * 16384, X.WG() + (size_t)((dir * 2 + 0) * 8 + h) * 16384, 128, 128, (q >> 1) * 64, (q & 1) * 64, nullptr, tile);
            else transpose_tile(X.in(7) + (size_t)dh * 16384, X.WG() + (size_t)((dir * 2 + 1) * 8 + h) * 16384, 128, 128, (q >> 1) * 64, (q & 1) * 64, nullptr, tile); }
    }
    const size_t gtid = (size_t)blockIdx.x * NTHR + tid, gth = (size_t)gridDim.x * NTHR;
    for (size_t i = gtid; i < 8 * 16384; i += gth) { const float v = X.in(12)[i]; unsigned u = __float_as_uint(v); u += 0x7FFFu + ((u >> 16) & 1u); X.WS()[i] = (bf16_t)(u >> 16); }
    for (size_t i = gtid; i < 2048; i += gth) { const float nl = -X.in(9)[i]; const float sp = nl > 15.f ? nl : log1pf(__expf(nl)); X.cfac()[i] = -8.0f * sp; }
    for (int u = blockIdx.x; u < 96; u += gridDim.x) { const int n = u * 64 + (tid & 63), kg = tid >> 6; float s = 0.f;
#pragma unroll 8
        for (int k = kg; k < 1024; k += 8) s += X.in(18)[k] * X.in(19)[(size_t)k * 6144 + n];
        tile[kg * 64 + (tid & 63)] = s; __syncthreads();
        if (tid < 64) { float t = 0.f;
#pragma unroll
            for (int j = 0; j < 8; ++j) t += tile[j * 64 + tid]; X.bW()[n] = t; }
        __syncthreads(); }
    convert_x(slab_x(X, 0), X.XB());
}
__device__ __forceinline__ void colsum_job(const Ctx& X) {
    int tid = threadIdx.x; asm volatile("" : "+v"(tid));
    const int lane = tid & 63, gw = blockIdx.x * 8 + (tid >> 6), nw = gridDim.x * 8;
    for (int n = gw; n < 6144; n += nw) { const u32x4* p = (const u32x4*)(X.WupT() + (size_t)n * 1024) + lane * 2; float f[8], s = 0.f;
        unpack8(p[0], f);
#pragma unroll
        for (int j = 0; j < 8; ++j) s += f[j];
        unpack8(p[1], f);
#pragma unroll
        for (int j = 0; j < 8; ++j) s += f[j];
#pragma unroll
        for (int o = 32; o >= 1; o >>= 1) s += __shfl_xor(s, o);
        if (lane == 0) X.colsum()[n] = s; }
}

constexpr int XCF_LD = 132, XCB_LD = 136, XCB_OFF = 128 * XCF_LD * 4, CARRY_OFF = XCB_OFF + 128 * XCB_LD * 2;
template <int PASS, int DIR>
__device__ __forceinline__ void lru_dir(const Ctx& X, int c, int h, LAS unsigned char* lds, float (&hsum)[8][4]) {
    int tid = threadIdx.x; asm volatile("" : "+v"(tid)); const int lane = tid & 63, w = tid >> 6, fr = lane & 15, fq = lane >> 4;
    LAS float* XCF = (LAS float*)lds; LAS bf16_t* XCB = (LAS bf16_t*)(lds + XCB_OFF); LAS float* CARRY = (LAS float*)(lds + CARRY_OFF);
    const bf16_t* WgR = X.WG() + (size_t)((DIR * 2 + 0) * 8 + h) * 16384; const bf16_t* WgI = X.WG() + (size_t)((DIR * 2 + 1) * 8 + h) * 16384;
    bf16x8 BR[4], BI[4];
#pragma unroll
    for (int ks = 0; ks < 4; ++ks) { BR[ks] = *(const bf16x8*)(WgR + (16 * w + fr) * 128 + 32 * ks + 8 * fq); BI[ks] = *(const bf16x8*)(WgI + (16 * w + fr) * 128 + 32 * ks + 8 * fq); }
    const int ch = h * 128 + 16 * w + fr;
    const float ba = X.in(6)[DIR * 1024 + ch], bx = X.in(8)[DIR * 1024 + ch], cf2 = X.cfac()[DIR * 1024 + ch] * 1.4426950408889634f;
    float av[8][4], bv[8][4];
#pragma unroll
    for (int m = 0; m < 8; ++m) { f32x4 aR = {ba, ba, ba, ba}, aI = {bx, bx, bx, bx};
#pragma unroll
        for (int ks = 0; ks < 4; ++ks) { const bf16x8 a = *(const LAS bf16x8*)(XCB + (16 * m + fr) * XCB_LD + 32 * ks + 8 * fq);
            aR = __builtin_amdgcn_mfma_f32_16x16x32_bf16(a, BR[ks], aR, 0, 0, 0); aI = __builtin_amdgcn_mfma_f32_16x16x32_bf16(a, BI[ks], aI, 0, 0, 0); }
#pragma unroll
        for (int r = 0; r < 4; ++r) { const float rg = sigmoid_f(aR[r]), ig = sigmoid_f(aI[r]), a = __builtin_amdgcn_exp2f(cf2 * rg), om = 1.f - a * a;
            const float xc = XCF[(16 * m + 4 * fq + r) * XCF_LD + 16 * w + fr];
            av[m][r] = a; bv[m][r] = __builtin_amdgcn_sqrtf(om) * ig * xc; } }
    float carry = 0.f, CA = 1.f, CB = 0.f;
    if (PASS == 2) carry = CARRY[DIR * 128 + 16 * w + fr];
#pragma unroll
    for (int mm = 0; mm < 8; ++mm) { const int m = DIR == 0 ? mm : 7 - mm;
        float A, B;
        if (DIR == 0) { A = av[m][0]; B = bv[m][0];
#pragma unroll
            for (int r = 1; r < 4; ++r) { B = av[m][r] * B + bv[m][r]; A *= av[m][r]; } }
        else { A = av[m][3]; B = bv[m][3];
#pragma unroll
            for (int r = 2; r >= 0; --r) { B = av[m][r] * B + bv[m][r]; A *= av[m][r]; } }
        { const float A1 = DIR == 0 ? __shfl_up(A, 16) : __shfl_down(A, 16), B1 = DIR == 0 ? __shfl_up(B, 16) : __shfl_down(B, 16);
          if (DIR == 0 ? fq >= 1 : fq <= 2) { B = A * B1 + B; A = A1 * A; } }
        { const float A2 = DIR == 0 ? __shfl_up(A, 32) : __shfl_down(A, 32), B2 = DIR == 0 ? __shfl_up(B, 32) : __shfl_down(B, 32);
          if (DIR == 0 ? fq >= 2 : fq <= 1) { B = A * B2 + B; A = A2 * A; } }
        const float TA = __shfl(A, (DIR == 0 ? 48 : 0) + fr), TB = __shfl(B, (DIR == 0 ? 48 : 0) + fr);
        if (PASS == 1) { CB = TA * CB + TB; CA *= TA; }
        else {
            float EA = DIR == 0 ? __shfl_up(A, 16) : __shfl_down(A, 16), EB = DIR == 0 ? __shfl_up(B, 16) : __shfl_down(B, 16);
            if (DIR == 0 ? fq == 0 : fq == 3) { EA = 1.f; EB = 0.f; }
            float hc = EA * carry + EB;
            if (DIR == 0) {
#pragma unroll
                for (int r = 0; r < 4; ++r) { hc = av[m][r] * hc + bv[m][r]; hsum[m][r] += hc; } }
            else {
#pragma unroll
                for (int r = 3; r >= 0; --r) { hc = av[m][r] * hc + bv[m][r]; hsum[m][r] += hc; } }
            carry = TA * carry + TB;
        }
    }
    if (PASS == 1 && fq == 0) { X.sum()[(size_t)((c * 2 + DIR) * 2 + 0) * 1024 + ch] = CA; X.sum()[(size_t)((c * 2 + DIR) * 2 + 1) * 1024 + ch] = CB; }
}
template <int PASS>
__device__ __forceinline__ void lru_job(const Ctx& X, int s, int c, int h, LAS unsigned char* lds) {
    int tid = threadIdx.x; asm volatile("" : "+v"(tid));
    LAS float* XCF = (LAS float*)lds; LAS bf16_t* XCB = (LAS bf16_t*)(lds + XCB_OFF); LAS float* CARRY = (LAS float*)(lds + CARRY_OFF);
    const int L = slab_seqlen(s), t0 = c * 128, sb = (t0 / L) * L, se = sb + L;
    const int cg8 = tid & 15, rg = tid >> 4, ch0 = h * 128 + cg8 * 8;
    u32x4 gpre[4];
    if (PASS == 2) {
#pragma unroll
        for (int r = 0; r < 4; ++r) gpre[r] = *(const u32x4*)(X.Z() + (size_t)(t0 + 4 * rg + r) * INW + ch0); }
    {
        float cw[4][8], cb[8];
#pragma unroll
        for (int k = 0; k < 4; ++k) { const f32x4 a = *(const f32x4*)(X.in(3) + k * 1024 + ch0), b = *(const f32x4*)(X.in(3) + k * 1024 + ch0 + 4);
#pragma unroll
            for (int j = 0; j < 4; ++j) { cw[k][j] = a[j]; cw[k][4 + j] = b[j]; } }
        { const f32x4 a = *(const f32x4*)(X.in(4) + ch0), b = *(const f32x4*)(X.in(4) + ch0 + 4);
#pragma unroll
          for (int j = 0; j < 4; ++j) { cb[j] = a[j]; cb[4 + j] = b[j]; } }
        float xin[7][8];
#pragma unroll
        for (int j = 0; j < 7; ++j) { const int t = t0 + 4 * rg - 2 + j; u32x4 wv = {0u, 0u, 0u, 0u};
            if (t >= sb && t < se) wv = *(const u32x4*)(X.Z() + (size_t)t * INW + 1024 + ch0);
            unpack8(wv, xin[j]); }
#pragma unroll
        for (int r = 0; r < 4; ++r) { float v[8];
#pragma unroll
            for (int e = 0; e < 8; ++e) v[e] = cb[e] + cw[0][e] * xin[r][e] + cw[1][e] * xin[r + 1][e] + cw[2][e] * xin[r + 2][e] + cw[3][e] * xin[r + 3][e];
            LAS float* o = XCF + (4 * rg + r) * XCF_LD + cg8 * 8;
            *(LAS f32x4*)o = (f32x4){v[0], v[1], v[2], v[3]}; *(LAS f32x4*)(o + 4) = (f32x4){v[4], v[5], v[6], v[7]};
            *(LAS u32x4*)(XCB + (4 * rg + r) * XCB_LD + cg8 * 8) = pack8(v); }
    }
    if (PASS == 2) {
        const int dir = (tid >> 7) & 1, half = tid >> 8, chn = h * 128 + (tid & 127), c_first = sb / 128, c_last = se / 128 - 1;
        const int n = dir == 0 ? c - c_first : c_last - c, n0 = half == 0 ? 0 : n / 2, n1 = half == 0 ? n / 2 : n;
        float PA = 1.f, PB = 0.f;
#pragma unroll 32
        for (int i = n0; i < n1; ++i) { const int cc = dir == 0 ? c_first + i : c_last - i;
            const float A = X.sum()[(size_t)((cc * 2 + dir) * 2 + 0) * 1024 + chn], Bv = X.sum()[(size_t)((cc * 2 + dir) * 2 + 1) * 1024 + chn]; PB = A * PB + Bv; PA *= A; }
        LAS float* CP = CARRY + 256;
        CP[(half * 256 + (tid & 255)) * 2] = PA; CP[(half * 256 + (tid & 255)) * 2 + 1] = PB;
    }
    __syncthreads();
    if (PASS == 2 && tid < 256) { LAS float* CP = CARRY + 256; const float B0 = CP[tid * 2 + 1], A1 = CP[(256 + tid) * 2], B1 = CP[(256 + tid) * 2 + 1]; CARRY[tid] = A1 * B0 + B1; }
    if (PASS == 2) __syncthreads();
    __syncthreads();
    float hsum[8][4];
#pragma unroll
    for (int m = 0; m < 8; ++m)
#pragma unroll
        for (int r = 0; r < 4; ++r) hsum[m][r] = 0.f;
    lru_dir<PASS, 0>(X, c, h, lds, hsum);
    lru_dir<PASS, 1>(X, c, h, lds, hsum);
    if (PASS == 2) {
        const int lane = tid & 63, w = tid >> 6, fr = lane & 15, fq = lane >> 4;
#pragma unroll
        for (int m = 0; m < 8; ++m)
#pragma unroll
            for (int r = 0; r < 4; ++r) XCF[(16 * m + 4 * fq + r) * XCF_LD + 16 * w + fr] = hsum[m][r];
        __syncthreads();
#pragma unroll
        for (int r = 0; r < 4; ++r) { const int tok = 4 * rg + r; LAS const float* y = XCF + tok * XCF_LD + cg8 * 8; const f32x4 y0 = *(LAS const f32x4*)y, y1 = *(LAS const f32x4*)(y + 4);
            float g[8]; unpack8(gpre[r], g);
            float v[8];
#pragma unroll
            for (int j = 0; j < 4; ++j) { v[j] = y0[j] * g[j]; v[4 + j] = y1[j] * g[4 + j]; }
            *(u32x4*)(X.YA() + (size_t)(t0 + tok) * 2048 + ch0) = pack8(v); }
    }
    __syncthreads();
}

__device__ __forceinline__ int vt_off(int d, int q) { return d * 136 + (((q >> 3) ^ ((d >> 3) & 15)) << 3) + (q & 7); }
__device__ __forceinline__ void gmlp_job(const Ctx& X, int c, int g, LAS unsigned char* lds) {
    int tid = threadIdx.x; asm volatile("" : "+v"(tid)); const int lane = tid & 63, w = tid >> 6, fr = lane & 15, fq = lane >> 4;
    LAS float* SV = (LAS float*)lds; LAS bf16_t* VT = (LAS bf16_t*)(lds + XCB_OFF); LAS float* MU = (LAS float*)(lds + CARRY_OFF);
    const int t0 = c * 128, cg8 = tid & 15, rg = tid >> 4, ch0 = g * 128 + cg8 * 8;
    if (tid < 128) { const float* p = X.vst() + (size_t)(t0 + tid) * 32; float s = 0.f, q = 0.f;
#pragma unroll
        for (int i = 0; i < 8; ++i) { const f32x4 a = *(const f32x4*)(p + 4 * i); s += a[0] + a[2]; q += a[1] + a[3]; }
        const float mean = s * (1.f / 1024.f), var = q * (1.f / 1024.f) - mean * mean; MU[tid * 2] = mean; MU[tid * 2 + 1] = rsqrtf(var + LN_EPS); }
    u32x4 vraw[4], uraw[4];
#pragma unroll
    for (int r = 0; r < 4; ++r) { vraw[r] = *(const u32x4*)(X.Z() + (size_t)(t0 + 4 * rg + r) * INW + 3072 + ch0); uraw[r] = *(const u32x4*)(X.Z() + (size_t)(t0 + 4 * rg + r) * INW + 2048 + ch0); }
    bf16x8 Aw[4];
#pragma unroll
    for (int ks = 0; ks < 4; ++ks) Aw[ks] = *(const bf16x8*)(X.WS() + (size_t)g * 16384 + (16 * w + fr) * 128 + 32 * ks + 8 * fq);
    __syncthreads();
    {
        float lg[8], lb[8], vn[4][8];
        { const f32x4 a = *(const f32x4*)(X.in(10) + ch0), b = *(const f32x4*)(X.in(10) + ch0 + 4), cc = *(const f32x4*)(X.in(11) + ch0), d = *(const f32x4*)(X.in(11) + ch0 + 4);
#pragma unroll
          for (int j = 0; j < 4; ++j) { lg[j] = a[j]; lg[4 + j] = b[j]; lb[j] = cc[j]; lb[4 + j] = d[j]; } }
#pragma unroll
        for (int r = 0; r < 4; ++r) { const int tok = 4 * rg + r; float v[8]; unpack8(vraw[r], v);
            const float mean = MU[tok * 2], rstd = MU[tok * 2 + 1];
#pragma unroll
            for (int e = 0; e < 8; ++e) vn[r][e] = (v[e] - mean) * rstd * lg[e] + lb[e]; }
#pragma unroll
        for (int e = 0; e < 8; ++e) { u32x2 pk; pk.x = cvt_pk_bf16(vn[0][e], vn[1][e]); pk.y = cvt_pk_bf16(vn[2][e], vn[3][e]); *(LAS u32x2*)(VT + vt_off(cg8 * 8 + e, 4 * rg)) = pk; }
    }
    __syncthreads();
    f32x4 acc[8];
#pragma unroll
    for (int dt = 0; dt < 8; ++dt) { acc[dt] = (f32x4){0.f, 0.f, 0.f, 0.f};
#pragma unroll
        for (int ks = 0; ks < 4; ++ks) { const bf16x8 b = *(const LAS bf16x8*)(VT + vt_off(16 * dt + fr, 32 * ks + 8 * fq)); acc[dt] = __builtin_amdgcn_mfma_f32_16x16x32_bf16(Aw[ks], b, acc[dt], 0, 0, 0); } }
#pragma unroll
    for (int dt = 0; dt < 8; ++dt)
#pragma unroll
        for (int r = 0; r < 4; ++r) SV[(16 * w + 4 * fq + r) * XCF_LD + 16 * dt + fr] = acc[dt][r];
    __syncthreads();
#pragma unroll
    for (int r = 0; r < 4; ++r) { const int tok = 4 * rg + r; LAS const float* y = SV + tok * XCF_LD + cg8 * 8; const f32x4 y0 = *(LAS const f32x4*)y, y1 = *(LAS const f32x4*)(y + 4);
        float uu[8]; unpack8(uraw[r], uu); const float bsv = X.in(13)[g * 128 + tok];
        float v[8];
#pragma unroll
        for (int j = 0; j < 4; ++j) { v[j] = uu[j] * (y0[j] + bsv); v[4 + j] = uu[4 + j] * (y1[j] + bsv); }
        *(u32x4*)(X.YA() + (size_t)(t0 + tok) * 2048 + 1024 + ch0) = pack8(v); }
    __syncthreads();
}

__device__ __forceinline__ void convgate_phase(const Ctx& X, int s) {
    const bf16_t* HUP = X.Z(); const float* cwp = X.in(20); const float* cbp = X.in(21);
    const int L = slab_seqlen(s);
    int tid = threadIdx.x; asm volatile("" : "+v"(tid));
    const int gtid = blockIdx.x * NTHR + tid, gth = gridDim.x * NTHR;
    for (int item = gtid; item < 2048 * 384; item += gth) { const int rb = item / 384, cgp = item - rb * 384, j0 = cgp * 8, r0 = rb * 8, sb = (r0 / L) * L, se = sb + L;
        u32x4 rg_[10], rv_[10];
#pragma unroll
        for (int i = 0; i < 10; ++i) { const int r = r0 - 1 + i; rg_[i] = (u32x4){0u, 0u, 0u, 0u}; rv_[i] = (u32x4){0u, 0u, 0u, 0u};
            if (r >= sb && r < se) { rg_[i] = *(const u32x4*)(HUP + (size_t)r * INW + j0); rv_[i] = *(const u32x4*)(HUP + (size_t)r * INW + 3072 + j0); } }
        float wg[3][8], wv[3][8], bg[8], bvv[8];
#pragma unroll
        for (int k = 0; k < 3; ++k) { const f32x4 a = *(const f32x4*)(cwp + k * 6144 + j0), b = *(const f32x4*)(cwp + k * 6144 + j0 + 4), c2 = *(const f32x4*)(cwp + k * 6144 + 3072 + j0), d = *(const f32x4*)(cwp + k * 6144 + 3072 + j0 + 4);
#pragma unroll
            for (int j = 0; j < 4; ++j) { wg[k][j] = a[j]; wg[k][4 + j] = b[j]; wv[k][j] = c2[j]; wv[k][4 + j] = d[j]; } }
        { const f32x4 a = *(const f32x4*)(cbp + j0), b = *(const f32x4*)(cbp + j0 + 4), c2 = *(const f32x4*)(cbp + 3072 + j0), d = *(const f32x4*)(cbp + 3072 + j0 + 4);
#pragma unroll
          for (int j = 0; j < 4; ++j) { bg[j] = a[j]; bg[4 + j] = b[j]; bvv[j] = c2[j]; bvv[4 + j] = d[j]; } }
        float pg[8], pv[8], cg_[8], cv[8], ng[8], nv[8];
        unpack8(rg_[0], pg); unpack8(rv_[0], pv); unpack8(rg_[1], cg_); unpack8(rv_[1], cv);
#pragma unroll
        for (int i = 0; i < 8; ++i) { unpack8(rg_[i + 2], ng); unpack8(rv_[i + 2], nv); float o[8];
#pragma unroll
            for (int e = 0; e < 8; ++e) { const float yg = bg[e] + wg[0][e] * pg[e] + wg[1][e] * cg_[e] + wg[2][e] * ng[e], yv = bvv[e] + wv[0][e] * pv[e] + wv[1][e] * cv[e] + wv[2][e] * nv[e];
                o[e] = gelu_f(yg) * yv; pg[e] = cg_[e]; cg_[e] = ng[e]; pv[e] = cv[e]; cv[e] = nv[e]; }
            *(u32x4*)(X.ACT() + (size_t)(r0 + i) * DFF + j0) = pack8(o); }
    }
}
__device__ __forceinline__ void final_ln(const Ctx& X, int s) {
    int tid = threadIdx.x; asm volatile("" : "+v"(tid));
    float* outs = slab_out(X, s); const int lane = tid & 63, gw = blockIdx.x * 8 + (tid >> 6), nw = gridDim.x * 8;
    f32x4 g[4], b[4];
#pragma unroll
    for (int i = 0; i < 4; ++i) { g[i] = *(const f32x4*)(X.in(23) + i * 256 + lane * 4); b[i] = *(const f32x4*)(X.in(24) + i * 256 + lane * 4); }
    for (int row = gw; row < TS; row += nw) { float sv = 0.f, qv = 0.f;
        if (lane < 16) { const f32x2v p = *(const f32x2v*)(X.st2() + ((size_t)row * 16 + lane) * 2); sv = p.x; qv = p.y; }
#pragma unroll
        for (int o = 8; o >= 1; o >>= 1) { sv += __shfl_xor(sv, o); qv += __shfl_xor(qv, o); }
        sv = __shfl(sv, 0); qv = __shfl(qv, 0);
        const float mean = sv * (1.f / 1024.f), rstd = rsqrtf(qv * (1.f / 1024.f) - mean * mean + LN_EPS);
        float* p = outs + (size_t)row * DM + lane * 4;
#pragma unroll
        for (int i = 0; i < 4; ++i) { const f32x4 v = *(const f32x4*)(p + i * 256); *(f32x4*)(p + i * 256) = (v - mean) * rstd * g[i] + b[i]; } }
}

constexpr int N_PHASES = 34;
#ifndef PMASK
#define PMASK 0x3ff
#endif
__global__ void __launch_bounds__(NTHR, 2) mega(Params p) {
    extern __shared__ __attribute__((aligned(16))) unsigned char lds_raw[];
    LAS unsigned char* lds = (LAS unsigned char*)lds_raw;
    cg::grid_group grid = cg::this_grid();
    Ctx X; X.p = p;
    const int G = gridDim.x, bx = blockIdx.x;
    unsigned* bar = (unsigned*)(p.ws + WS_BAR); unsigned bar_target = 0u;
    if (bx == 0 && threadIdx.x == 0) __hip_atomic_store(bar, 0u, __ATOMIC_RELAXED, __HIP_MEMORY_SCOPE_AGENT);
    for (int ph = 0; ph < N_PHASES; ++ph) {
        if (ph == 1) grid.sync(); else if (ph > 1) grid_barrier(bar, bar_target);
        if (ph == 0) { if (PMASK & 0x100) phase_prep(X, lds); continue; }
        if (ph == N_PHASES - 1) { if (PMASK & 0x200) final_ln(X, NSLAB - 1); continue; }
        const int s = (ph - 1) >> 3, k = (ph - 1) & 7;
        {
        if (k == 0 && (PMASK & 1)) {
            pg8::Gemm g{X.XB(), X.WinT(), TS, INW, DM}; pg8::StaticOrder S; S.init(TS, INW, G, bx); EpiZ E{X.Z(), X.vst()};
            pg8::gemm_phase<EpiZ, pg8::StaticOrder>(lds, g, S, E);
        } else if (k == 1 && (PMASK & 2)) {
            if (s == 0) colsum_job(X); else final_ln(X, s - 1);
            for (int j = bx; j < 1024; j += G) lru_job<1>(X, s, j >> 3, j & 7, lds);
            for (int j = bx; j < 1024; j += G) gmlp_job(X, j >> 3, j & 7, lds);
        } else if (k == 2 && (PMASK & 4)) {
            for (int j = bx; j < 1024; j += G) lru_job<2>(X, s, j >> 3, j & 7, lds);
        } else if (k == 3 && (PMASK & 8)) {
            pg8::Gemm g{X.YA(), X.PaT(), TS, DM, 2048}; pg8::StaticOrder S; S.init(TS, DM, G, bx); EpiProj E{X.Z(), X.MG()}; pg8::gemm_phase<EpiProj, pg8::StaticOrder>(lds, g, S, E);
        } else if (k == 4 && (PMASK & 16)) {
            pg8::Gemm g{X.MG(), X.WoT(), TS, DM, DM}; pg8::StaticOrder S; S.init(TS, DM, G, bx); EpiOut1 E{slab_x(X, s), slab_out(X, s), X.YA(), X.st1()};
            pg8::gemm_phase<EpiOut1, pg8::StaticOrder>(lds, g, S, E);
        } else if (k == 5 && (PMASK & 32)) {
            pg8::Gemm g{X.YA(), X.WupT(), TS, INW, DM}; pg8::StaticOrder S; S.init(TS, INW, G, bx); EpiUp E{X.Z(), X.st1(), X.colsum(), X.bW()};
            pg8::gemm_phase<EpiUp, pg8::StaticOrder>(lds, g, S, E);
        } else if (k == 6 && (PMASK & 64)) {
            convgate_phase(X, s); if (s + 1 < NSLAB) convert_x(slab_x(X, s + 1), X.XB());
        } else if (PMASK & 128) {
            pg8::Gemm g{X.ACT(), X.WdT(), TS, DM, DFF}; pg8::StaticOrder S; S.init(TS, DM, G, bx); EpiDown E{slab_out(X, s), slab_out(X, s), X.st1(), X.st2(), X.in(17), X.in(18)};
            pg8::gemm_phase<EpiDown, pg8::StaticOrder>(lds, g, S, E);
        }
        }
    }
}

extern "C" void kernel_launch(void* const* d_in, const int* in_sizes, int n_in, void* d_out, int out_size, void* d_ws, size_t ws_size, hipStream_t stream) {
    constexpr int LDS_BYTES = pg8::STAGE_BYTES;
    static int grid = 0;
    if (grid == 0) {
        int dev = 0, cus = 0, per_cu = 0;
        if (n_in != 25 || ws_size < WS_BAR + 256) { fprintf(stderr, "kernel_launch: need 25 inputs and %zu bytes of workspace (got %d, %zu)\n", (size_t)WS_BAR + 256, n_in, ws_size); grid = -1; return; }
        (void)hipGetDevice(&dev); (void)hipDeviceGetAttribute(&cus, hipDeviceAttributeMultiprocessorCount, dev);
        (void)hipFuncSetAttribute((const void*)mega, hipFuncAttributeMaxDynamicSharedMemorySize, LDS_BYTES);
        (void)hipOccupancyMaxActiveBlocksPerMultiprocessor(&per_cu, (const void*)mega, NTHR, LDS_BYTES);
        grid = cus;
    }
    if (grid < 0) return;
    Params p{};
    for (int i = 0; i < 25; ++i) p.in[i] = (const float*)d_in[i];
    p.out = (float*)d_out; p.ws = (unsigned char*)d_ws;
    void* args[] = {&p};
    hipError_t e = hipLaunchCooperativeKernel((const void*)mega, dim3(grid), dim3(NTHR), args, LDS_BYTES, stream);
    if (e != hipSuccess) fprintf(stderr, "cooperative launch failed: %s (grid %d)\n", hipGetErrorString(e), grid);
}
```
